# Optimizing an MI355X kernel written in HIP

```python
import jax, jax.numpy as jnp
from jax import lax
import numpy as np

D_MODEL = 2048
BATCH = 4
SEQ = 4096
DEPTH = 2

N_MIXERS = 2
N_GMLP_LAYERS = (DEPTH + 1) // 2
N_SWA_LAYERS = DEPTH // 2
D_FF = 5632
FFN_RESIDUAL_WEIGHT = 0.5
PLE_DIM = 256
RMS_EPS = 1e-6
LN_EPS = 1e-5
CHUNK = 128
GMLP_WIDTH = 2 * D_MODEL
GMLP_GROUPS = 16
GMLP_GROUP_DIM = GMLP_WIDTH // GMLP_GROUPS
N_Q_HEADS = 32
N_KV_HEADS = 4
HEAD_DIM = 64
Q_PER_KV = N_Q_HEADS // N_KV_HEADS
WINDOW = 128
ROPE_THETA = 500000.0
ROPE_DIM = HEAD_DIM // 4

kernel_name = "hybrid_gmlp_swa_sink_macaron"


def rms_norm(x, g):
    xf = x.astype(jnp.float32)
    y = xf * lax.rsqrt(jnp.mean(xf * xf, axis=-1, keepdims=True) + RMS_EPS)
    return (y * g.astype(jnp.float32)).astype(x.dtype)


def layer_norm(x, g, b):
    xf = x.astype(jnp.float32)
    mu = jnp.mean(xf, axis=-1, keepdims=True)
    var = jnp.mean(jnp.square(xf - mu), axis=-1, keepdims=True)
    y = (xf - mu) * lax.rsqrt(var + LN_EPS)
    return (y * g.astype(jnp.float32) + b.astype(jnp.float32)).astype(x.dtype)


def swiglu(h, w1, w3, w2):
    return (jax.nn.silu(h @ w1) * (h @ w3)) @ w2


def gmlp_chunk_mixer(h, w_in, ln_g, ln_b, w_s, b_s, w_out):
    B, S, _ = h.shape
    z = jax.nn.gelu(h @ w_in, approximate=False)
    u, v = jnp.split(z, 2, axis=-1)
    v = layer_norm(v, ln_g, ln_b)
    v = v.reshape(B, S // CHUNK, CHUNK, GMLP_GROUPS, GMLP_GROUP_DIM)
    causal = jnp.tril(jnp.ones((CHUNK, CHUNK), dtype=bool))
    w = jnp.where(causal[None], w_s, jnp.zeros((), w_s.dtype))
    s = jnp.einsum('gts,bcsgd->bctgd', w, v) + b_s.T[:, :, None]
    gated = u * s.reshape(B, S, GMLP_WIDTH)
    return gated @ w_out


def rope_tables(S):
    inv_freq = ROPE_THETA ** (-jnp.arange(0, ROPE_DIM, 2, dtype=jnp.float32) / ROPE_DIM)
    ang = jnp.arange(S, dtype=jnp.float32)[:, None] * inv_freq[None, :]
    return jnp.cos(ang), jnp.sin(ang)


def apply_partial_rope(x, cos, sin):
    half = ROPE_DIM // 2
    c = cos[:, None, :].astype(x.dtype)
    s = sin[:, None, :].astype(x.dtype)
    x1 = x[..., :half]
    x2 = x[..., half:ROPE_DIM]
    return jnp.concatenate([x1 * c - x2 * s, x2 * c + x1 * s, x[..., ROPE_DIM:]], axis=-1)


def swa_sink_attention(h, wq, bq, wk, bk, wv, bv, sinks, wo, bo):
    B, S, _ = h.shape
    NB = S // WINDOW
    q = (h @ wq + bq).reshape(B, S, N_Q_HEADS, HEAD_DIM)
    k = (h @ wk + bk).reshape(B, S, N_KV_HEADS, HEAD_DIM)
    v = (h @ wv + bv).reshape(B, S, N_KV_HEADS, HEAD_DIM)
    cos, sin = rope_tables(S)
    q = apply_partial_rope(q, cos, sin)
    k = apply_partial_rope(k, cos, sin)
    q = q.reshape(B, NB, WINDOW, N_KV_HEADS, Q_PER_KV, HEAD_DIM)
    k = k.reshape(B, NB, WINDOW, N_KV_HEADS, HEAD_DIM)
    v = v.reshape(B, NB, WINDOW, N_KV_HEADS, HEAD_DIM)
    pad = ((0, 0), (1, 0), (0, 0), (0, 0), (0, 0))
    kb = jnp.concatenate([jnp.pad(k, pad)[:, :-1], k], axis=2)
    vb = jnp.concatenate([jnp.pad(v, pad)[:, :-1], v], axis=2)
    scores = jnp.einsum('bnqkgd,bnskd->bnkgqs', q, kb).astype(jnp.float32) * (HEAD_DIM ** -0.5)
    qpos = jnp.arange(WINDOW)[:, None] + WINDOW
    kpos = jnp.arange(2 * WINDOW)[None, :]
    diff = qpos - kpos
    band = (diff >= 0) & (diff < WINDOW)
    has_prev = (jnp.arange(NB) > 0)[:, None, None]
    valid = jnp.where(has_prev, band[None], (band & (kpos >= WINDOW))[None])
    scores = jnp.where(valid[None, :, None, None], scores, -jnp.inf)
    sink = sinks.astype(jnp.float32).reshape(N_KV_HEADS, Q_PER_KV)[None, None, :, :, None, None]
    m = jnp.maximum(jnp.max(scores, axis=-1, keepdims=True), sink)
    e = jnp.exp(scores - m)
    denom = jnp.sum(e, axis=-1, keepdims=True) + jnp.exp(sink - m)
    probs = (e / denom).astype(vb.dtype)
    o = jnp.einsum('bnkgqs,bnskd->bnqkgd', probs, vb).reshape(B, S, N_Q_HEADS * HEAD_DIM)
    return o @ wo + bo


def per_layer_embedding(x, p_i, g, w_gate, w_proj):
    gate = jax.nn.sigmoid(rms_norm(x, g) @ w_gate)
    return gate * (p_i @ w_proj)


def setup_inputs(seed: int = 0) -> dict:
    key = jax.random.key(seed)
    ks = iter(jax.random.split(key, 40))
    f32 = jnp.float32

    def dense(shape, scale=1.0):
        return jax.random.normal(next(ks), shape, f32) * (scale * shape[-2] ** -0.5)

    def gain(shape):
        return 1.0 + 0.02 * jax.random.normal(next(ks), shape, f32)

    def bias(shape, s=0.02):
        return s * jax.random.normal(next(ks), shape, f32)

    out_scale = (2.0 * DEPTH) ** -0.5
    NA, NBL = N_GMLP_LAYERS, N_SWA_LAYERS
    QW = N_Q_HEADS * HEAD_DIM
    KW = N_KV_HEADS * HEAD_DIM
    return {
        "x": jax.random.normal(next(ks), (BATCH, SEQ, D_MODEL), f32),
        "p": jax.random.normal(next(ks), (DEPTH, BATCH, SEQ, PLE_DIM), f32),
        "ffn1_norm": gain((DEPTH, D_MODEL)),
        "ffn1_w1": dense((DEPTH, D_MODEL, D_FF)),
        "ffn1_w3": dense((DEPTH, D_MODEL, D_FF)),
        "ffn1_w2": dense((DEPTH, D_FF, D_MODEL), out_scale),
        "mix_norm": gain((DEPTH, D_MODEL)),
        "ffn2_norm": gain((DEPTH, D_MODEL)),
        "ffn2_w1": dense((DEPTH, D_MODEL, D_FF)),
        "ffn2_w3": dense((DEPTH, D_MODEL, D_FF)),
        "ffn2_w2": dense((DEPTH, D_FF, D_MODEL), out_scale),
        "ple_norm": gain((DEPTH, D_MODEL)),
        "ple_w_gate": dense((DEPTH, D_MODEL, D_MODEL)),
        "ple_w_proj": dense((DEPTH, PLE_DIM, D_MODEL), out_scale),
        "gmlp_w_in": dense((NA, D_MODEL, 2 * GMLP_WIDTH)),
        "gmlp_ln_g": gain((NA, GMLP_WIDTH)),
        "gmlp_ln_b": bias((NA, GMLP_WIDTH)),
        "gmlp_w_s": dense((NA, GMLP_GROUPS, CHUNK, CHUNK), 0.5),
        "gmlp_b_s": 1.0 + bias((NA, GMLP_GROUPS, CHUNK)),
        "gmlp_w_out": dense((NA, GMLP_WIDTH, D_MODEL), out_scale),
        "swa_wq": dense((NBL, D_MODEL, QW)),
        "swa_bq": bias((NBL, QW)),
        "swa_wk": dense((NBL, D_MODEL, KW)),
        "swa_bk": bias((NBL, KW)),
        "swa_wv": dense((NBL, D_MODEL, KW)),
        "swa_bv": bias((NBL, KW)),
        "swa_sinks": 0.5 * jax.random.normal(next(ks), (NBL, N_Q_HEADS), f32),
        "swa_wo": dense((NBL, QW, D_MODEL), out_scale),
        "swa_bo": bias((NBL, D_MODEL)),
        "final_norm": gain((D_MODEL,)),
    }


def reference(x, p, ffn1_norm, ffn1_w1, ffn1_w3, ffn1_w2, mix_norm,
              ffn2_norm, ffn2_w1, ffn2_w3, ffn2_w2,
              ple_norm, ple_w_gate, ple_w_proj,
              gmlp_w_in, gmlp_ln_g, gmlp_ln_b, gmlp_w_s, gmlp_b_s, gmlp_w_out,
              swa_wq, swa_bq, swa_wk, swa_bk, swa_wv, swa_bv, swa_sinks, swa_wo, swa_bo,
              final_norm):
    for i in range(DEPTH):
        x = x + FFN_RESIDUAL_WEIGHT * swiglu(rms_norm(x, ffn1_norm[i]), ffn1_w1[i], ffn1_w3[i], ffn1_w2[i])
        h = rms_norm(x, mix_norm[i])
        j = i // N_MIXERS
        if i % N_MIXERS == 0:
            x = x + gmlp_chunk_mixer(h, gmlp_w_in[j], gmlp_ln_g[j], gmlp_ln_b[j],
                                     gmlp_w_s[j], gmlp_b_s[j], gmlp_w_out[j])
        else:
            x = x + swa_sink_attention(h, swa_wq[j], swa_bq[j], swa_wk[j], swa_bk[j],
                                       swa_wv[j], swa_bv[j], swa_sinks[j], swa_wo[j], swa_bo[j])
        x = x + FFN_RESIDUAL_WEIGHT * swiglu(rms_norm(x, ffn2_norm[i]), ffn2_w1[i], ffn2_w3[i], ffn2_w2[i])
        x = x + per_layer_embedding(x, p[i], ple_norm[i], ple_w_gate[i], ple_w_proj[i])
    return rms_norm(x, final_norm)
```

```cpp
#include <hip/hip_runtime.h>
#include <cstdio>
#include <cstdint>
#include <cmath>
namespace pg8 {
#define PG8_LAS __attribute__((address_space(3)))
typedef unsigned short bf16_t;
typedef short bf16x8 __attribute__((ext_vector_type(8)));
typedef float f32x4 __attribute__((ext_vector_type(4)));
typedef unsigned u32x4 __attribute__((ext_vector_type(4)));
constexpr int BM = 256, BK = 64, HALF = 128, HTB = HALF * BK * 2  , STAGE_BYTES = 8 * HTB, NXCD = 8, WGM = 8;

__host__ __device__ __forceinline__ int lds_byte(int r, int c) { const int st = (r >> 4) * 2 + (c >> 5), rr = r & 15, cc = c & 31, ob = rr * 64 + cc * 2; return st * 1024 + (ob ^ (((ob >> 9) & 1) << 5)); }
__host__ __device__ __forceinline__ void stage_rc(int b, int& R, int& C) { const int st = b / 1024, sb = b % 1024, swz = sb ^ (((sb >> 9) & 1) << 5); R = (st >> 1) * 16 + swz / 64; C = (st & 1) * 32 + (swz % 64) / 2; }
__host__ __device__ __forceinline__ int perm32(int rho) { const int n = rho >> 4, i = rho & 15; return 8 * (i >> 2) + 4 * n + (i & 3); }

struct Unit { int pm, pn; };
struct Gemm { const bf16_t* A; const bf16_t* Bt; int M, N, K, lda; };

struct StaticOrder {
    int nM, nN, nwg, G, c;
    __host__ __device__ void init(int M, int N, int G_, int c_) { nM = M / BM; nN = N / BM; nwg = nM * nN; G = G_; c = c_; }
    __host__ __device__ bool next(int i, Unit& u) const {
        const long L = (long)i * G + c; if (L >= nwg) return false;
        int wgid = (int)L; { const int q = nwg / NXCD, r = nwg % NXCD, xcd = wgid % NXCD, off = wgid / NXCD; wgid = (xcd < r ? xcd * (q + 1) : r * (q + 1) + (xcd - r) * q) + off; }
        const int nig = WGM * nN, gid = wgid / nig, fm = gid * WGM, gsz = (nM - fm) < WGM ? (nM - fm) : WGM;
        u.pm = fm + ((wgid % nig) % gsz); u.pn = (wgid % nig) / gsz; return true;
    }
    __device__ __forceinline__ void a_ready(const Unit&) const {}
    __device__ __forceinline__ void done(const Unit&) const {}
};

__device__ __forceinline__ unsigned cvt_pk_bf16(float lo, float hi) { unsigned r; asm volatile("v_cvt_pk_bf16_f32 %0, %1, %2" : "=v"(r) : "v"(lo), "v"(hi)); return r; }
typedef float f32x2 __attribute__((ext_vector_type(2)));
__device__ __forceinline__ f32x2 gelu_pk(f32x2 v) {
    const f32x2 av = __builtin_elementwise_abs(v), d = av * 0.2316418882f + 1.0f;
    f32x2 t; t.x = __builtin_amdgcn_rcpf(d.x); t.y = __builtin_amdgcn_rcpf(d.y);
    f32x2 q = t * 0.5307027145f + (-0.7265760135f); q = q * t + 0.7107068705f; q = q * t + (-0.142248368f); q = q * t + 0.127414796f; q = q * t;
    const f32x2 s = (v * v) * (-0.72134752044f);
    f32x2 e; e.x = __builtin_amdgcn_exp2f(s.x); e.y = __builtin_amdgcn_exp2f(s.y);
    const f32x2 m = v * (q * e), r = v - m;
    f32x2 o; o.x = v.x < 0.f ? m.x : r.x; o.y = v.y < 0.f ? m.y : r.y; return o;
}
constexpr int XD = 2048;
typedef unsigned u32x2 __attribute__((ext_vector_type(2)));
__device__ __forceinline__ float row_rstd(const float* ssqp, int row, int fq) {
    const f32x4* p = (const f32x4*)(ssqp + (size_t)row * 32 + fq * 8);
    const f32x4 a = p[0], b = p[1];
    float s = ((a[0] + a[1]) + (a[2] + a[3])) + ((b[0] + b[1]) + (b[2] + b[3]));
    s += __shfl_xor(s, 16); s += __shfl_xor(s, 32);
    return __builtin_amdgcn_rsqf(s * (1.0f / 2048.0f) + 1e-6f);
}
__device__ __forceinline__ float sigmoid_f(float z) { return __builtin_amdgcn_rcpf(1.0f + __builtin_amdgcn_exp2f(z * -1.4426950408889634f)); }
__device__ __forceinline__ u32x4 pack8(const f32x4& v0, const f32x4& v1) { u32x4 w; w.x = cvt_pk_bf16(v0[0], v0[1]); w.y = cvt_pk_bf16(v0[2], v0[3]); w.z = cvt_pk_bf16(v1[0], v1[1]); w.w = cvt_pk_bf16(v1[2], v1[3]); return w; }
__device__ __forceinline__ float bf_lo(unsigned w) { return __uint_as_float(w << 16); }
__device__ __forceinline__ float bf_hi(unsigned w) { return __uint_as_float(w & 0xffff0000u); }

struct EpiSwiGLU {
    static constexpr bool PERM = true, AFTER_DRAIN = false;
    bf16_t* H; int ldh; const float* ssqp;
    __device__ __forceinline__ void operator()(const f32x4 (&acc)[2][2][4][2], const Unit& u, int wr, int wc, int fr, int fq) const {
        const int row0 = u.pm * BM + wr * 64 + fr, col0 = u.pn * HALF + wc * 32 + 8 * fq;
#pragma unroll
        for (int ai = 0; ai < 2; ++ai)
#pragma unroll
            for (int m = 0; m < 4; ++m) { const int row = row0 + ai * HALF + m * 16; const float rs = row_rstd(ssqp, row, fq);
                f32x4 h[2];
#pragma unroll
                for (int n = 0; n < 2; ++n) { const f32x4 a = acc[ai][0][m][n] * rs, b = acc[ai][1][m][n] * rs;
#pragma unroll
                    for (int e = 0; e < 4; ++e) h[n][e] = a[e] * b[e] * sigmoid_f(a[e]); }
                *(u32x4*)(H + (size_t)row * ldh + col0) = pack8(h[0], h[1]); }
    }
};
struct EpiResid {
    static constexpr bool PERM = true, AFTER_DRAIN = false;
    const float* xin; float* xout; bf16_t* xb; float* ssq_out; const float* bias; float alpha;
    __device__ __forceinline__ void operator()(const f32x4 (&acc)[2][2][4][2], const Unit& u, int wr, int wc, int fr, int fq) const {
        const int row0 = u.pm * BM + wr * 64 + fr, col0 = u.pn * BM + wc * 32 + 8 * fq;
        f32x4 bv[2][2];
#pragma unroll
        for (int bj = 0; bj < 2; ++bj)
#pragma unroll
            for (int n = 0; n < 2; ++n) bv[bj][n] = bias ? *(const f32x4*)(bias + col0 + bj * HALF + 4 * n) : (f32x4){0.f, 0.f, 0.f, 0.f};
#pragma unroll
        for (int ai = 0; ai < 2; ++ai)
#pragma unroll
            for (int m = 0; m < 4; ++m) { const int row = row0 + ai * HALF + m * 16; const size_t off = (size_t)row * XD + col0; float ss = 0.f;
#pragma unroll
                for (int bj = 0; bj < 2; ++bj) {
                    const f32x4 x0 = *(const f32x4*)(xin + off + bj * HALF), x1 = *(const f32x4*)(xin + off + bj * HALF + 4);
                    const f32x4 v0 = x0 + acc[ai][bj][m][0] * alpha + bv[bj][0], v1 = x1 + acc[ai][bj][m][1] * alpha + bv[bj][1];
                    *(f32x4*)(xout + off + bj * HALF) = v0; *(f32x4*)(xout + off + bj * HALF + 4) = v1;
                    *(u32x4*)(xb + off + bj * HALF) = pack8(v0, v1);
                    ss += (v0[0] * v0[0] + v0[1] * v0[1]) + (v0[2] * v0[2] + v0[3] * v0[3]) + (v1[0] * v1[0] + v1[1] * v1[1]) + (v1[2] * v1[2] + v1[3] * v1[3]); }
                ss += __shfl_xor(ss, 16); ss += __shfl_xor(ss, 32);
                if (fq == 0) ssq_out[(size_t)row * 32 + u.pn * 4 + wc] = ss;
                if (m & 1) asm volatile("" ::: "memory"); }
    }
};
struct EpiGelu {
    static constexpr bool PERM = true, AFTER_DRAIN = false;
    bf16_t* Z; int ldz; const float* ssqp; float* vstat;
    __device__ __forceinline__ void operator()(const f32x4 (&acc)[2][2][4][2], const Unit& u, int wr, int wc, int fr, int fq) const {
        const int row0 = u.pm * BM + wr * 64 + fr, col0 = u.pn * BM + wc * 32 + 8 * fq;
#pragma unroll
        for (int ai = 0; ai < 2; ++ai)
#pragma unroll
            for (int m = 0; m < 4; ++m) { const int row = row0 + ai * HALF + m * 16; const float rs = row_rstd(ssqp, row, fq); float s1 = 0.f, s2 = 0.f;
#pragma unroll
                for (int bj = 0; bj < 2; ++bj) { f32x4 v0 = acc[ai][bj][m][0] * rs, v1 = acc[ai][bj][m][1] * rs;
                    const f32x2 a = gelu_pk((f32x2){v0[0], v0[1]}), b = gelu_pk((f32x2){v0[2], v0[3]}), c = gelu_pk((f32x2){v1[0], v1[1]}), d = gelu_pk((f32x2){v1[2], v1[3]});
                    v0 = (f32x4){a.x, a.y, b.x, b.y}; v1 = (f32x4){c.x, c.y, d.x, d.y};
                    *(u32x4*)(Z + (size_t)row * ldz + col0 + bj * HALF) = pack8(v0, v1);
                    s1 += ((v0[0] + v0[1]) + (v0[2] + v0[3])) + ((v1[0] + v1[1]) + (v1[2] + v1[3]));
                    s2 += (v0[0] * v0[0] + v0[1] * v0[1]) + (v0[2] * v0[2] + v0[3] * v0[3]) + (v1[0] * v1[0] + v1[1] * v1[1]) + (v1[2] * v1[2] + v1[3] * v1[3]); }
                if (u.pn >= 16) { s1 += __shfl_xor(s1, 16); s1 += __shfl_xor(s1, 32); s2 += __shfl_xor(s2, 16); s2 += __shfl_xor(s2, 32);
                    if (fq == 0) *(f32x2*)(vstat + ((size_t)row * 64 + (u.pn - 16) * 4 + wc) * 2) = (f32x2){s1, s2}; } }
    }
};
struct EpiQKV {
    static constexpr bool PERM = true, AFTER_DRAIN = false;
    bf16_t* O; int ldo; const float* ssqp; const float* bq; const float* bk; const float* bv;
    __device__ __forceinline__ void operator()(const f32x4 (&acc)[2][2][4][2], const Unit& u, int wr, int wc, int fr, int fq) const {
        const int row0 = u.pm * BM + wr * 64 + fr, cin = wc * 32 + 8 * fq, col0 = u.pn * BM + cin;
        const float* bp = bq ? (u.pn < 8 ? bq + u.pn * BM : (u.pn == 8 ? bk : bv)) + cin : nullptr;
        f32x4 bvv[2][2];
#pragma unroll
        for (int bj = 0; bj < 2; ++bj)
#pragma unroll
            for (int n = 0; n < 2; ++n) bvv[bj][n] = bp ? *(const f32x4*)(bp + bj * HALF + 4 * n) : (f32x4){0.f, 0.f, 0.f, 0.f};
#pragma unroll
        for (int ai = 0; ai < 2; ++ai)
#pragma unroll
            for (int m = 0; m < 4; ++m) { const int row = row0 + ai * HALF + m * 16; const float rs = ssqp ? row_rstd(ssqp, row, fq) : 1.0f;
#pragma unroll
                for (int bj = 0; bj < 2; ++bj) *(u32x4*)(O + (size_t)row * ldo + col0 + bj * HALF) = pack8(acc[ai][bj][m][0] * rs + bvv[bj][0], acc[ai][bj][m][1] * rs + bvv[bj][1]); }
    }
};
struct EpiPLE {
    static constexpr bool PERM = true, AFTER_DRAIN = false;
    float* x; bf16_t* xb; float* ssq_out; const float* ssqp; const bf16_t* pj;
    __device__ __forceinline__ void operator()(const f32x4 (&acc)[2][2][4][2], const Unit& u, int wr, int wc, int fr, int fq) const {
        const int row0 = u.pm * BM + wr * 64 + fr, col0 = u.pn * BM + wc * 32 + 8 * fq;
#pragma unroll
        for (int ai = 0; ai < 2; ++ai)
#pragma unroll
            for (int m = 0; m < 4; ++m) { const int row = row0 + ai * HALF + m * 16; const size_t off = (size_t)row * XD + col0; const float rs = row_rstd(ssqp, row, fq); float ss = 0.f;
#pragma unroll
                for (int bj = 0; bj < 2; ++bj) {
                    const f32x4 x0 = *(const f32x4*)(x + off + bj * HALF), x1 = *(const f32x4*)(x + off + bj * HALF + 4);
                    const u32x4 pw = *(const u32x4*)(pj + off + bj * HALF);
                    const f32x4 p0 = (f32x4){bf_lo(pw.x), bf_hi(pw.x), bf_lo(pw.y), bf_hi(pw.y)}, p1 = (f32x4){bf_lo(pw.z), bf_hi(pw.z), bf_lo(pw.w), bf_hi(pw.w)};
                    f32x4 v0, v1;
#pragma unroll
                    for (int e = 0; e < 4; ++e) { v0[e] = x0[e] + sigmoid_f(acc[ai][bj][m][0][e] * rs) * p0[e]; v1[e] = x1[e] + sigmoid_f(acc[ai][bj][m][1][e] * rs) * p1[e]; }
                    *(f32x4*)(x + off + bj * HALF) = v0; *(f32x4*)(x + off + bj * HALF + 4) = v1;
                    *(u32x4*)(xb + off + bj * HALF) = pack8(v0, v1);
                    ss += (v0[0] * v0[0] + v0[1] * v0[1]) + (v0[2] * v0[2] + v0[3] * v0[3]) + (v1[0] * v1[0] + v1[1] * v1[1]) + (v1[2] * v1[2] + v1[3] * v1[3]); }
                ss += __shfl_xor(ss, 16); ss += __shfl_xor(ss, 32);
                if (fq == 0) ssq_out[(size_t)row * 32 + u.pn * 4 + wc] = ss;
                if (m & 1) asm volatile("" ::: "memory"); }
    }
};

template <class Epi, class Sched, bool ALIGN_EPI = false, bool SP2 = false>
__device__ __forceinline__ void gemm_phase(PG8_LAS unsigned char* lds, const Gemm g, const Sched& S, const Epi& E) {
    const int tid = threadIdx.x, wid = __builtin_amdgcn_readfirstlane(tid >> 6), lane = tid & 63, wr = wid >> 2, wc = wid & 3, fr = lane & 15, fq = lane >> 4;
    const int K = g.K, nt = K / BK;
    unsigned voffA[2], voffB[2];
#pragma unroll
    for (int i = 0; i < 2; ++i) { int R, C; stage_rc(tid * 16 + i * 8192, R, C); const int Rb = Epi::PERM ? ((R & ~31) + perm32(R & 31)) : R;
        voffA[i] = (unsigned)(R * g.lda + C) * 2u; voffB[i] = (unsigned)(Rb * K + C) * 2u; }
    const size_t kstep = (size_t)(BK * 2);
    const size_t hstepA = (size_t)HALF * g.lda * 2, hstepB = (size_t)HALF * K * 2;
    const size_t tstepA = 2 * hstepA, tstepB = 2 * hstepB;
    const unsigned ldsw = (unsigned)wid * 1024u;
    const int aoff = lds_byte(wr * 64 + fr, fq * 8), boff = lds_byte(wc * 32 + fr, fq * 8);
#define PG8_SA(b, h) (((b) * 2 + (h)) * HTB)
#define PG8_SB(b, h) ((4 + (b) * 2 + (h)) * HTB)
#define PG8_STAGE(bufoff, gbase, voff) do { _Pragma("unroll") for (int _i = 0; _i < 2; ++_i) \
        __builtin_amdgcn_global_load_lds((const unsigned*)((const char*)(gbase) + (voff)[_i]), (PG8_LAS unsigned*)(lds + (bufoff) + ldsw + _i * 8192), 16, 0, 0); } while (0)
#define PG8_LDA(dst, b, h) do { _Pragma("unroll") for (int m = 0; m < 4; ++m) _Pragma("unroll") for (int k = 0; k < 2; ++k) dst[m][k] = *(const PG8_LAS bf16x8*)(lds + PG8_SA(b, h) + aoff + m * 2048 + k * 1024); } while (0)
#define PG8_LDB(dst, b, h) do { _Pragma("unroll") for (int n = 0; n < 2; ++n) _Pragma("unroll") for (int k = 0; k < 2; ++k) dst[n][k] = *(const PG8_LAS bf16x8*)(lds + PG8_SB(b, h) + boff + n * 2048 + k * 1024); } while (0)
#define PG8_MMA(ai, bj, At, Bt) do { __builtin_amdgcn_s_setprio(1); _Pragma("unroll") for (int m = 0; m < 4; ++m) _Pragma("unroll") for (int n = 0; n < 2; ++n) _Pragma("unroll") for (int k = 0; k < 2; ++k) \
        acc[ai][bj][m][n] = __builtin_amdgcn_mfma_f32_16x16x32_bf16(Bt[n][k], At[m][k], acc[ai][bj][m][n], 0, 0, 0); __builtin_amdgcn_s_setprio(0); } while (0)
#define PG8_WAIT_V(n) asm volatile("s_waitcnt vmcnt(" #n ")" ::: "memory")
#define PG8_WAIT_L(n) asm volatile("s_waitcnt lgkmcnt(" #n ")" ::: "memory")
#define PG8_BAR __builtin_amdgcn_s_barrier()
#define PG8_SCHED __builtin_amdgcn_sched_barrier(0)
    Unit cur, nxt; int ui = 0;
    if (!S.next(0, cur)) return;
    f32x4 acc[2][2][4][2];
#pragma unroll
    for (int a = 0; a < 2; ++a)
#pragma unroll
        for (int b = 0; b < 2; ++b)
#pragma unroll
            for (int m = 0; m < 4; ++m)
#pragma unroll
                for (int n = 0; n < 2; ++n) acc[a][b][m][n] = (f32x4){0.f, 0.f, 0.f, 0.f};
    bf16x8 At[4][2], B0[2][2], B1[2][2];
    const char* cA = (const char*)g.A + (size_t)cur.pm * tstepA; const char* cB = (const char*)g.Bt + (size_t)cur.pn * tstepB;
    S.a_ready(cur);
    if constexpr (SP2) {
        PG8_STAGE(PG8_SB(0, 0), cB, voffB); PG8_STAGE(PG8_SB(0, 1), cB + hstepB, voffB); PG8_STAGE(PG8_SA(0, 0), cA, voffA); PG8_STAGE(PG8_SA(0, 1), cA + hstepA, voffA);
        if (wr == 1) PG8_BAR;
        PG8_WAIT_V(2); PG8_BAR;
        PG8_STAGE(PG8_SB(1, 0), cB + kstep, voffB); PG8_STAGE(PG8_SA(1, 0), cA + kstep, voffA); PG8_STAGE(PG8_SB(1, 1), cB + hstepB + kstep, voffB);
        PG8_WAIT_V(6); PG8_BAR;
    } else {
        PG8_STAGE(PG8_SB(0, 0), cB, voffB); PG8_STAGE(PG8_SA(0, 0), cA, voffA); PG8_STAGE(PG8_SB(0, 1), cB + hstepB, voffB); PG8_STAGE(PG8_SA(0, 1), cA + hstepA, voffA);
        if (wr == 1) PG8_BAR;
        PG8_WAIT_V(4); PG8_BAR;
        PG8_STAGE(PG8_SB(1, 0), cB + kstep, voffB); PG8_STAGE(PG8_SA(1, 0), cA + kstep, voffA); PG8_STAGE(PG8_SB(1, 1), cB + hstepB + kstep, voffB);
        PG8_WAIT_V(6); PG8_BAR;
    }
    for (;;) {
        const bool has_next = S.next(ui + 1, nxt);
        const char* nA = has_next ? (const char*)g.A + (size_t)nxt.pm * tstepA : cA; const char* nB = has_next ? (const char*)g.Bt + (size_t)nxt.pn * tstepB : cB;
        for (int t = 0; t < nt; t += 2) {
            const bool last = (t == nt - 2);
            const char* a1 = cA + (size_t)(t + 1) * kstep;
            const char* a2 = last ? nA : cA + (size_t)(t + 2) * kstep; const char* b2 = last ? nB : cB + (size_t)(t + 2) * kstep;
            const char* a3 = a2 + kstep; const char* b3 = b2 + kstep;
            if (last && has_next) S.a_ready(nxt);
            if constexpr (SP2) {
            PG8_LDB(B0, 0, 0); PG8_LDB(B1, 0, 1); PG8_SCHED; PG8_LDA(At, 0, 0); PG8_STAGE(PG8_SA(1, 1), a1 + hstepA, voffA);
            PG8_WAIT_V(8); PG8_WAIT_L(0); PG8_BAR; PG8_MMA(0, 0, At, B0); PG8_MMA(0, 1, At, B1); PG8_BAR; PG8_SCHED;
            PG8_LDA(At, 0, 1); PG8_STAGE(PG8_SB(0, 0), b2, voffB); PG8_STAGE(PG8_SB(0, 1), b2 + hstepB, voffB); PG8_STAGE(PG8_SA(0, 0), a2, voffA);
            PG8_WAIT_V(8); PG8_WAIT_L(0); PG8_BAR; PG8_MMA(1, 0, At, B0); PG8_MMA(1, 1, At, B1); PG8_BAR; PG8_SCHED;
            PG8_LDB(B0, 1, 0); PG8_LDB(B1, 1, 1); PG8_SCHED; PG8_LDA(At, 1, 0); PG8_STAGE(PG8_SA(0, 1), a2 + hstepA, voffA);
            PG8_WAIT_V(8); PG8_WAIT_L(0); PG8_BAR; PG8_MMA(0, 0, At, B0); PG8_MMA(0, 1, At, B1); PG8_BAR; PG8_SCHED;
            PG8_LDA(At, 1, 1); PG8_STAGE(PG8_SB(1, 0), b3, voffB); PG8_STAGE(PG8_SB(1, 1), b3 + hstepB, voffB); PG8_STAGE(PG8_SA(1, 0), a3, voffA);
            PG8_WAIT_V(8); PG8_WAIT_L(0); PG8_BAR; PG8_MMA(1, 0, At, B0); PG8_MMA(1, 1, At, B1); PG8_BAR; PG8_SCHED;
            } else {
            PG8_LDB(B0, 0, 0); PG8_SCHED; PG8_LDA(At, 0, 0); PG8_STAGE(PG8_SA(1, 1), a1 + hstepA, voffA);
            PG8_WAIT_L(8); PG8_BAR; PG8_WAIT_L(0); PG8_MMA(0, 0, At, B0); PG8_BAR; PG8_SCHED;
            PG8_LDB(B1, 0, 1); PG8_STAGE(PG8_SB(0, 0), b2, voffB);
            PG8_BAR; PG8_WAIT_L(0); PG8_MMA(0, 1, At, B1); PG8_BAR;
            PG8_LDA(At, 0, 1); PG8_STAGE(PG8_SA(0, 0), a2, voffA);
            PG8_BAR; PG8_WAIT_L(0); PG8_MMA(1, 0, At, B0); PG8_BAR; PG8_SCHED;
            PG8_STAGE(PG8_SB(0, 1), b2 + hstepB, voffB);
            PG8_WAIT_V(6); PG8_BAR; PG8_MMA(1, 1, At, B1); PG8_BAR;
            PG8_LDB(B0, 1, 0); PG8_SCHED; PG8_LDA(At, 1, 0); PG8_STAGE(PG8_SA(0, 1), a2 + hstepA, voffA);
            PG8_WAIT_L(8); PG8_BAR; PG8_WAIT_L(0); PG8_MMA(0, 0, At, B0); PG8_BAR; PG8_SCHED;
            PG8_LDB(B1, 1, 1); PG8_STAGE(PG8_SB(1, 0), b3, voffB);
            PG8_BAR; PG8_WAIT_L(0); PG8_MMA(0, 1, At, B1); PG8_BAR;
            PG8_LDA(At, 1, 1); PG8_STAGE(PG8_SA(1, 0), a3, voffA);
            PG8_BAR; PG8_WAIT_L(0); PG8_MMA(1, 0, At, B0); PG8_BAR; PG8_SCHED;
            PG8_STAGE(PG8_SB(1, 1), b3 + hstepB, voffB);
            PG8_WAIT_V(6); PG8_BAR; PG8_MMA(1, 1, At, B1); PG8_BAR;
            }
        }
        if constexpr (ALIGN_EPI) { if (wr == 0) PG8_BAR; }
        if constexpr (!Epi::AFTER_DRAIN) { E(acc, cur, wr, wc, fr, fq); S.done(cur); }
        if (!has_next) break;
#pragma unroll
        for (int a = 0; a < 2; ++a)
#pragma unroll
            for (int b = 0; b < 2; ++b)
#pragma unroll
                for (int m = 0; m < 4; ++m)
#pragma unroll
                    for (int n = 0; n < 2; ++n) acc[a][b][m][n] = (f32x4){0.f, 0.f, 0.f, 0.f};
        cur = nxt; cA = nA; cB = nB; ++ui;
        if constexpr (ALIGN_EPI) { if (wr == 1) PG8_BAR; }
    }
    PG8_WAIT_V(0);
    if constexpr (!ALIGN_EPI) { if (wr == 0) PG8_BAR; }
    PG8_BAR;
    if constexpr (Epi::AFTER_DRAIN) { E.fused(acc, cur, wr, wc, fr, fq, lds, wid, lane); S.done(cur); }
#undef PG8_SA
#undef PG8_SB
#undef PG8_STAGE
#undef PG8_LDA
#undef PG8_LDB
#undef PG8_MMA
#undef PG8_WAIT_V
#undef PG8_WAIT_L
#undef PG8_BAR
#undef PG8_SCHED
}
}
#include <hip/hip_cooperative_groups.h>
namespace cg = cooperative_groups;
#ifndef MK_MULTI
#define MK_MULTI 1
#endif
#define LAS __attribute__((address_space(3)))
typedef unsigned short bf16;
typedef float f32x4 __attribute__((ext_vector_type(4)));
typedef float f32x2 __attribute__((ext_vector_type(2)));
typedef unsigned u32x4 __attribute__((ext_vector_type(4)));
typedef unsigned u32x2 __attribute__((ext_vector_type(2)));
typedef short bf16x8 __attribute__((ext_vector_type(8)));
typedef short s16x4 __attribute__((ext_vector_type(4)));

constexpr int BATCH = 4, SEQ = 4096, M = BATCH * SEQ, D = 2048, FF = 5632, PLE = 256, GW = 4096, NQH = 32, NKV = 4, HD = 64, QKVW = 2560;
constexpr int NPHASE = 18;
constexpr size_t MiB = 1u << 20;
constexpr size_t WS_ROPE = 1 * MiB, WS_SS0 = 2 * MiB, WS_SS1 = 4 * MiB, WS_VSTAT = 6 * MiB, WS_PB = 16 * MiB, WS_XB0 = 32 * MiB, WS_XB1 = 96 * MiB, WS_PJ = 160 * MiB, WS_BIG = 224 * MiB;
constexpr size_t WS_W13 = 480 * MiB, SZ_W13 = (size_t)2 * FF * D * 2;
constexpr size_t WS_W2 = WS_W13 + 4 * SZ_W13, SZ_W2 = (size_t)D * FF * 2;
constexpr size_t WS_WG = WS_W2 + 4 * SZ_W2, SZ_WG = (size_t)D * D * 2;
constexpr size_t WS_WP = WS_WG + 2 * SZ_WG, SZ_WP = (size_t)D * PLE * 2;
constexpr size_t WS_WIN = WS_WP + 2 * SZ_WP, WS_WOUT = WS_WIN + (size_t)2 * GW * D * 2, WS_WQKV = WS_WOUT + (size_t)D * GW * 2, WS_WO = WS_WQKV + (size_t)QKVW * D * 2, WS_END = WS_WO + (size_t)D * D * 2;
constexpr int LDS_BYTES = 135168;

__device__ __forceinline__ unsigned f2bf(float f) { unsigned u = __builtin_bit_cast(unsigned, f); return (u + 0x7fffu + ((u >> 16) & 1u)) >> 16; }
__device__ __forceinline__ unsigned pk2(float lo, float hi) { return f2bf(lo) | (f2bf(hi) << 16); }
__device__ __forceinline__ float bflo(unsigned w) { return __uint_as_float(w << 16); }
__device__ __forceinline__ float bfhi(unsigned w) { return __uint_as_float(w & 0xffff0000u); }
__device__ __forceinline__ float wave_sum(float v) {
#pragma unroll
    for (int o = 1; o < 64; o <<= 1) v += __shfl_xor(v, o);
    return v;
}
#define LDS_WAIT() asm volatile("s_waitcnt lgkmcnt(0)" ::: "memory")

struct Args { const float* in[30]; float* out; unsigned char* ws; float invf[8]; int lo, hi; };

__device__ __forceinline__ void transpose_item(const float* W, int K, int N, bf16* WT, const float* gain, int mode, int row_off, LAS float* scr, int item, int lane) {
    const int nblk = N / 32, kb = item / nblk, nb = item % nblk, k0 = 64 * kb, n0 = 32 * nb;
#pragma unroll 8
    for (int i = 0; i < 32; ++i) { const int kk = 2 * i + (lane >> 5); float v = W[(size_t)(k0 + kk) * N + n0 + (lane & 31)]; if (gain) v *= gain[k0 + kk]; scr[kk * 33 + (lane & 31)] = v; }
    LDS_WAIT(); asm volatile("" ::: "memory");
    const int c = lane & 7;
#pragma unroll
    for (int j = 0; j < 4; ++j) { const int n = (lane >> 3) + 8 * j; const LAS float* s = scr + (8 * c) * 33 + n;
        u32x4 o; o.x = pk2(s[0 * 33], s[1 * 33]); o.y = pk2(s[2 * 33], s[3 * 33]); o.z = pk2(s[4 * 33], s[5 * 33]); o.w = pk2(s[6 * 33], s[7 * 33]);
        const int ng = n0 + n, drow = mode ? (((ng >> 7) << 8) + (ng & 127) + row_off) : (row_off + ng);
        *(u32x4*)(WT + (size_t)drow * K + k0 + 8 * c) = o; }
    LDS_WAIT(); asm volatile("" ::: "memory");
}
__device__ __forceinline__ void p0_prologue(const Args& a, LAS unsigned char* lds) {
    const int tid = threadIdx.x, lane = tid & 63, wave = tid >> 6, G = gridDim.x;
    LAS float* scr = (LAS float*)(lds + wave * 16384);
    const int gw = blockIdx.x * 8 + wave, NGW = G * 8;
    unsigned char* ws = a.ws;
    constexpr int I_UP = (D / 64) * (FF / 32), I_DN = (FF / 64) * (D / 32), I_DD = (D / 64) * (D / 32), I_PJ = (PLE / 64) * (D / 32), I_IN = (D / 64) * (2 * GW / 32), I_OUT = (GW / 64) * (D / 32), I_KV = (D / 64) * (256 / 32);
    constexpr int I_LAYER = 4 * I_UP + 2 * I_DN + I_DD + I_PJ;
    constexpr int NITEMS = 2 * I_LAYER + I_IN + I_OUT + 2 * I_DD + 2 * I_KV;
    for (int it = gw; it < NITEMS; it += NGW) {
        int r = it; const float* src = nullptr; int K = 0, N = 0; bf16* dst = nullptr; const float* gain = nullptr; int mode = 0, off = 0; bool hit = false;
#define JOB(CNT, SRC, KK, NN, DST, GAIN, MODE, OFF) if (!hit) { if (r < (CNT)) { src = (SRC); K = (KK); N = (NN); dst = (bf16*)(DST); gain = (GAIN); mode = (MODE); off = (OFF); hit = true; } else r -= (CNT); }
        if (r < 2 * I_LAYER) { const int l = r / I_LAYER; r -= l * I_LAYER;
            JOB(I_UP, a.in[3] + (size_t)l * D * FF, D, FF, ws + WS_W13 + (size_t)(0 * 2 + l) * SZ_W13, a.in[2] + l * D, 1, 0)
            JOB(I_UP, a.in[4] + (size_t)l * D * FF, D, FF, ws + WS_W13 + (size_t)(0 * 2 + l) * SZ_W13, a.in[2] + l * D, 1, 128)
            JOB(I_DN, a.in[5] + (size_t)l * D * FF, FF, D, ws + WS_W2 + (size_t)(0 * 2 + l) * SZ_W2, nullptr, 0, 0)
            JOB(I_UP, a.in[8] + (size_t)l * D * FF, D, FF, ws + WS_W13 + (size_t)(1 * 2 + l) * SZ_W13, a.in[7] + l * D, 1, 0)
            JOB(I_UP, a.in[9] + (size_t)l * D * FF, D, FF, ws + WS_W13 + (size_t)(1 * 2 + l) * SZ_W13, a.in[7] + l * D, 1, 128)
            JOB(I_DN, a.in[10] + (size_t)l * D * FF, FF, D, ws + WS_W2 + (size_t)(1 * 2 + l) * SZ_W2, nullptr, 0, 0)
            JOB(I_DD, a.in[12] + (size_t)l * D * D, D, D, ws + WS_WG + (size_t)l * SZ_WG, a.in[11] + l * D, 0, 0)
            JOB(I_PJ, a.in[13] + (size_t)l * PLE * D, PLE, D, ws + WS_WP + (size_t)l * SZ_WP, nullptr, 0, 0)
        } else { r -= 2 * I_LAYER;
            JOB(I_IN, a.in[14], D, 2 * GW, ws + WS_WIN, a.in[6], 0, 0)
            JOB(I_OUT, a.in[19], GW, D, ws + WS_WOUT, nullptr, 0, 0)
            JOB(I_DD, a.in[20], D, D, ws + WS_WQKV, a.in[6] + D, 0, 0)
            JOB(I_KV, a.in[22], D, 256, ws + WS_WQKV, a.in[6] + D, 0, 2048)
            JOB(I_KV, a.in[24], D, 256, ws + WS_WQKV, a.in[6] + D, 0, 2304)
            JOB(I_DD, a.in[27], D, D, ws + WS_WO, nullptr, 0, 0)
        }
#undef JOB
        if (hit) transpose_item(src, K, N, dst, gain, mode, off, scr, r, lane);
    }
    { const float* x = a.in[0]; bf16* xb = (bf16*)(ws + WS_XB0); float* ss0 = (float*)(ws + WS_SS0);
      for (int m = gw; m < M; m += NGW) { const f32x4* xr = (const f32x4*)(x + (size_t)m * D) + lane; u32x2* o8 = (u32x2*)(xb + (size_t)m * D) + lane; float s = 0.f;
#pragma unroll
          for (int j = 0; j < 8; ++j) { const f32x4 v = xr[64 * j]; s += (v[0] * v[0] + v[1] * v[1]) + (v[2] * v[2] + v[3] * v[3]); u32x2 w; w.x = pk2(v[0], v[1]); w.y = pk2(v[2], v[3]); o8[64 * j] = w; }
          s = wave_sum(s); if (lane < 32) ss0[(size_t)m * 32 + lane] = lane == 0 ? s : 0.f; } }
    { const float* p = a.in[1]; bf16* pb = (bf16*)(ws + WS_PB); const size_t n8 = (size_t)2 * M * PLE / 8;
      for (size_t i = (size_t)blockIdx.x * 512 + tid; i < n8; i += (size_t)G * 512) { const f32x4 v0 = *(const f32x4*)(p + i * 8), v1 = *(const f32x4*)(p + i * 8 + 4);
          u32x4 w; w.x = pk2(v0[0], v0[1]); w.y = pk2(v0[2], v0[3]); w.z = pk2(v1[0], v1[1]); w.w = pk2(v1[2], v1[3]); *(u32x4*)(pb + i * 8) = w; } }
    { f32x2* rt = (f32x2*)(ws + WS_ROPE);
      for (int i = blockIdx.x * 512 + tid; i < SEQ * 8; i += G * 512) { const int pos = i >> 3, j = i & 7;
          const float ang = __fmul_rn((float)pos, a.invf[j]); const double rev = (double)ang * 0.15915494309189535; const float fr = (float)(rev - __builtin_rint(rev));
          rt[i] = (f32x2){__builtin_amdgcn_cosf(fr), __builtin_amdgcn_sinf(fr)}; } }
}

__device__ __forceinline__ s16x4 tr_read(const LAS bf16* p) { return __builtin_bit_cast(s16x4, __builtin_amdgcn_ds_read_tr16_b64_v4i16((LAS s16x4*)p)); }

__device__ __forceinline__ void spatial_phase(LAS unsigned char* lds, bf16* Z, const float* vstat, const float* lng, const float* lnb, const float* wsp, const float* bsp) {
    const int tid = threadIdx.x, lane = tid & 63, wid = tid >> 6, fr = lane & 15, fq = lane >> 4, q4 = (lane & 15) >> 2, p4 = lane & 3;
    constexpr int WP = 136, VP = 272;
    LAS bf16* Wl = (LAS bf16*)lds;
    LAS bf16* Vl = (LAS bf16*)(lds + 128 * WP * 2);
    LAS float* MU = (LAS float*)(lds + 128 * WP * 2 + 128 * VP * 2);
    LAS float* RS = MU + 128;
    const int th = wid >> 2, cq = wid & 3;
    for (int idx = blockIdx.x; idx < (M / 128) * 16; idx += gridDim.x) {
        const int chunk = idx >> 4, g = idx & 15; const size_t rowb = (size_t)chunk * 128;
        { const int row = tid >> 2, qq = tid & 3; const f32x4* sp = (const f32x4*)(vstat + ((rowb + row) * 64 + qq * 16) * 2); float s1 = 0.f, s2 = 0.f;
#pragma unroll
          for (int j = 0; j < 8; ++j) { const f32x4 v = sp[j]; s1 += v[0] + v[2]; s2 += v[1] + v[3]; }
          s1 += __shfl_xor(s1, 1); s1 += __shfl_xor(s1, 2); s2 += __shfl_xor(s2, 1); s2 += __shfl_xor(s2, 2);
          const float mean = s1 * (1.0f / GW), var = fmaxf(s2 * (1.0f / GW) - mean * mean, 0.f);
          if (qq == 0) { MU[row] = mean; RS[row] = __builtin_amdgcn_rsqf(var + 1e-5f); } }
        { const float* wg = wsp + (size_t)g * 128 * 128;
#pragma unroll
          for (int j = 0; j < 8; ++j) { const int e = tid + 512 * j, t = e >> 5, s4 = (e & 31) * 4; f32x4 v = *(const f32x4*)(wg + t * 128 + s4);
#pragma unroll
              for (int k = 0; k < 4; ++k) if (s4 + k > t) v[k] = 0.f;
              u32x2 w; w.x = pk2(v[0], v[1]); w.y = pk2(v[2], v[3]); *(LAS u32x2*)(Wl + t * WP + s4) = w; } }
        __syncthreads();
        { const int c8 = (tid & 31) * 8; const int ch = g * 256 + c8;
          const f32x4 g0 = *(const f32x4*)(lng + ch), g1 = *(const f32x4*)(lng + ch + 4), b0 = *(const f32x4*)(lnb + ch), b1 = *(const f32x4*)(lnb + ch + 4);
#pragma unroll
          for (int j = 0; j < 8; ++j) { const int s = (tid >> 5) + 16 * j; const u32x4 w = *(const u32x4*)(Z + (rowb + s) * (2 * GW) + GW + ch); const float mu = MU[s], rs = RS[s];
              f32x4 v0 = (f32x4){bflo(w.x), bfhi(w.x), bflo(w.y), bfhi(w.y)}, v1 = (f32x4){bflo(w.z), bfhi(w.z), bflo(w.w), bfhi(w.w)};
              v0 = (v0 - mu) * rs * g0 + b0; v1 = (v1 - mu) * rs * g1 + b1;
              u32x4 o; o.x = pk2(v0[0], v0[1]); o.y = pk2(v0[2], v0[3]); o.z = pk2(v1[0], v1[1]); o.w = pk2(v1[2], v1[3]); *(LAS u32x4*)(Vl + s * VP + c8) = o; } }
        __syncthreads();
        f32x4 acc[4][4];
#pragma unroll
        for (int i = 0; i < 4; ++i)
#pragma unroll
            for (int j = 0; j < 4; ++j) acc[i][j] = (f32x4){0.f, 0.f, 0.f, 0.f};
#pragma unroll
        for (int ks = 0; ks < 4; ++ks) {
            bf16x8 wf[4], vf[4];
#pragma unroll
            for (int tt = 0; tt < 4; ++tt) wf[tt] = *(const LAS bf16x8*)(Wl + (th * 64 + tt * 16 + fr) * WP + ks * 32 + fq * 8);
#pragma unroll
            for (int ct = 0; ct < 4; ++ct) { const LAS bf16* vp = Vl + (ks * 32 + 8 * fq + q4) * VP + cq * 64 + ct * 16 + 4 * p4;
                const s16x4 lo = tr_read(vp), hi = tr_read(vp + 4 * VP); vf[ct] = (bf16x8){lo[0], lo[1], lo[2], lo[3], hi[0], hi[1], hi[2], hi[3]}; }
#pragma unroll
            for (int ct = 0; ct < 4; ++ct)
#pragma unroll
                for (int tt = 0; tt < 4; ++tt) acc[ct][tt] = __builtin_amdgcn_mfma_f32_16x16x32_bf16(vf[ct], wf[tt], acc[ct][tt], 0, 0, 0);
        }
#pragma unroll
        for (int tt = 0; tt < 4; ++tt) { const int t = th * 64 + tt * 16 + fr; const float bsv = bsp[g * 128 + t];
#pragma unroll
            for (int ct = 0; ct < 4; ++ct) { bf16* up = Z + (rowb + t) * (2 * GW) + g * 256 + cq * 64 + ct * 16 + 4 * fq; const u32x2 w = *(const u32x2*)up;
                u32x2 o; o.x = pk2(bflo(w.x) * (acc[ct][tt][0] + bsv), bfhi(w.x) * (acc[ct][tt][1] + bsv)); o.y = pk2(bflo(w.y) * (acc[ct][tt][2] + bsv), bfhi(w.y) * (acc[ct][tt][3] + bsv)); *(u32x2*)up = o; } }
        __syncthreads();
    }
}

__device__ __forceinline__ void attn_phase(LAS unsigned char* lds, const bf16* QKV, bf16* O, const float* rope, const float* sinks) {
    const int tid = threadIdx.x, lane = tid & 63, wid = tid >> 6, fr = lane & 15, fq = lane >> 4, q4 = (lane & 15) >> 2, p4 = lane & 3;
    constexpr int KP = 72;
    LAS bf16* Kl = (LAS bf16*)lds;
    LAS bf16* Vl = (LAS bf16*)(lds + 272 * KP * 2);
    const int NB = SEQ / 128;
    for (int idx = blockIdx.x; idx < BATCH * NB * NKV; idx += gridDim.x) {
        const int kh = idx & 3, nb = (idx >> 2) % NB, b = idx / (4 * NB);
        { const int r = tid >> 1, half = tid & 1; const int pos = (nb - 1) * 128 + r;
          u32x4 kw[4], vw[4];
          if (pos >= 0) { const bf16* kp = QKV + ((size_t)b * SEQ + pos) * QKVW + 2048 + kh * 64 + half * 32;
#pragma unroll
              for (int c = 0; c < 4; ++c) { kw[c] = *(const u32x4*)(kp + 8 * c); vw[c] = *(const u32x4*)(kp + 256 + 8 * c); }
              if (half == 0) { const f32x4* rp = (const f32x4*)(rope + (size_t)pos * 16);
                  const f32x4 r0 = rp[0], r1 = rp[1], r2 = rp[2], r3 = rp[3];
                  const float cs[8] = {r0[0], r0[2], r1[0], r1[2], r2[0], r2[2], r3[0], r3[2]}, sn[8] = {r0[1], r0[3], r1[1], r1[3], r2[1], r2[3], r3[1], r3[3]};
                  float x1[8], x2[8];
#pragma unroll
                  for (int e = 0; e < 4; ++e) { x1[2 * e] = bflo(kw[0][e]); x1[2 * e + 1] = bfhi(kw[0][e]); x2[2 * e] = bflo(kw[1][e]); x2[2 * e + 1] = bfhi(kw[1][e]); }
#pragma unroll
                  for (int e = 0; e < 4; ++e) { kw[0][e] = pk2(x1[2 * e] * cs[2 * e] - x2[2 * e] * sn[2 * e], x1[2 * e + 1] * cs[2 * e + 1] - x2[2 * e + 1] * sn[2 * e + 1]);
                                                kw[1][e] = pk2(x2[2 * e] * cs[2 * e] + x1[2 * e] * sn[2 * e], x2[2 * e + 1] * cs[2 * e + 1] + x1[2 * e + 1] * sn[2 * e + 1]); } }
          } else {
#pragma unroll
              for (int c = 0; c < 4; ++c) { kw[c] = (u32x4){0u, 0u, 0u, 0u}; vw[c] = (u32x4){0u, 0u, 0u, 0u}; } }
#pragma unroll
          for (int c = 0; c < 4; ++c) { *(LAS u32x4*)(Kl + r * KP + half * 32 + 8 * c) = kw[c]; *(LAS u32x4*)(Vl + r * KP + half * 32 + 8 * c) = vw[c]; }
          if (tid < 32) {
#pragma unroll
              for (int c = 0; c < 4; ++c) { *(LAS u32x4*)(Kl + (256 + r) * KP + half * 32 + 8 * c) = (u32x4){0u, 0u, 0u, 0u}; *(LAS u32x4*)(Vl + (256 + r) * KP + half * 32 + 8 * c) = (u32x4){0u, 0u, 0u, 0u}; } } }
        __syncthreads();
        const int qh = kh * 8 + wid; const float sink = sinks[qh];
        for (int a = 0; a < 8; ++a) {
            const int qi = a * 16 + fr, qpos_abs = nb * 128 + qi; const size_t qrow = (size_t)b * SEQ + qpos_abs;
            bf16x8 qf[2];
            { const bf16* qp = QKV + qrow * QKVW + qh * 64 + fq * 8; u32x4 w0 = *(const u32x4*)qp; const u32x4 w1 = *(const u32x4*)(qp + 32);
              const f32x4* rp = (const f32x4*)(rope + (size_t)qpos_abs * 16); const f32x4 r0 = rp[0], r1 = rp[1], r2 = rp[2], r3 = rp[3];
              const float cs[8] = {r0[0], r0[2], r1[0], r1[2], r2[0], r2[2], r3[0], r3[2]}, sn[8] = {r0[1], r0[3], r1[1], r1[3], r2[1], r2[3], r3[1], r3[3]};
              u32x4 pw; pw.x = __shfl_xor(w0.x, 16); pw.y = __shfl_xor(w0.y, 16); pw.z = __shfl_xor(w0.z, 16); pw.w = __shfl_xor(w0.w, 16);
              const float sg = fq == 0 ? -1.f : 1.f;
              u32x4 rw;
#pragma unroll
              for (int e = 0; e < 4; ++e) { const float xa = bflo(w0[e]), xb = bfhi(w0[e]), pa = bflo(pw[e]), pb = bfhi(pw[e]);
                  rw[e] = pk2(xa * cs[2 * e] + sg * pa * sn[2 * e], xb * cs[2 * e + 1] + sg * pb * sn[2 * e + 1]); }
              if (fq < 2) w0 = rw;
              qf[0] = __builtin_bit_cast(bf16x8, w0); qf[1] = __builtin_bit_cast(bf16x8, w1); }
            f32x4 sc[10];
#pragma unroll
            for (int j = 0; j < 10; ++j) { const LAS bf16* kp = Kl + ((a + j) * 16 + fr) * KP + fq * 8;
                f32x4 z = (f32x4){0.f, 0.f, 0.f, 0.f};
                z = __builtin_amdgcn_mfma_f32_16x16x32_bf16(*(const LAS bf16x8*)kp, qf[0], z, 0, 0, 0);
                z = __builtin_amdgcn_mfma_f32_16x16x32_bf16(*(const LAS bf16x8*)(kp + 32), qf[1], z, 0, 0, 0);
                sc[j] = z; }
            const int qpos = 128 + qi; float mx = -INFINITY;
#pragma unroll
            for (int j = 0; j < 10; ++j)
#pragma unroll
                for (int e = 0; e < 4; ++e) { const int kpos = (a + j) * 16 + 4 * fq + e; const bool valid = (kpos <= qpos) && (kpos > qpos - 128) && (nb > 0 || kpos >= 128);
                    const float s = valid ? sc[j][e] * 0.125f : -INFINITY; sc[j][e] = s; mx = fmaxf(mx, s); }
            mx = fmaxf(mx, __shfl_xor(mx, 16)); mx = fmaxf(mx, __shfl_xor(mx, 32)); mx = fmaxf(mx, sink);
            float l = 0.f;
#pragma unroll
            for (int j = 0; j < 10; ++j)
#pragma unroll
                for (int e = 0; e < 4; ++e) { const float p = __expf(sc[j][e] - mx); sc[j][e] = p; l += p; }
            l += __shfl_xor(l, 16); l += __shfl_xor(l, 32); l += __expf(sink - mx);
            const float rl = 1.0f / l;
            f32x4 oacc[4];
#pragma unroll
            for (int c = 0; c < 4; ++c) oacc[c] = (f32x4){0.f, 0.f, 0.f, 0.f};
#pragma unroll
            for (int j2 = 0; j2 < 5; ++j2) {
                u32x4 pwv; pwv.x = pk2(sc[2 * j2][0], sc[2 * j2][1]); pwv.y = pk2(sc[2 * j2][2], sc[2 * j2][3]); pwv.z = pk2(sc[2 * j2 + 1][0], sc[2 * j2 + 1][1]); pwv.w = pk2(sc[2 * j2 + 1][2], sc[2 * j2 + 1][3]);
                const bf16x8 pf = __builtin_bit_cast(bf16x8, pwv);
#pragma unroll
                for (int c = 0; c < 4; ++c) { const LAS bf16* vp = Vl + ((a + 2 * j2) * 16 + 4 * fq + q4) * KP + 16 * c + 4 * p4;
                    const s16x4 lo = tr_read(vp), hi = tr_read(vp + 16 * KP);
                    const bf16x8 vf = (bf16x8){lo[0], lo[1], lo[2], lo[3], hi[0], hi[1], hi[2], hi[3]};
                    oacc[c] = __builtin_amdgcn_mfma_f32_16x16x32_bf16(vf, pf, oacc[c], 0, 0, 0); }
            }
            bf16* op = O + qrow * D + qh * 64 + 4 * fq;
#pragma unroll
            for (int c = 0; c < 4; ++c) { u32x2 w; w.x = pk2(oacc[c][0] * rl, oacc[c][1] * rl); w.y = pk2(oacc[c][2] * rl, oacc[c][3] * rl); *(u32x2*)(op + 16 * c) = w; }
        }
        __syncthreads();
    }
}

__device__ __forceinline__ void final_phase(float* x, const float* ssq, const float* gn) {
    const int tid = threadIdx.x, lane = tid & 63, wave = tid >> 6; const int gw = blockIdx.x * 8 + wave, NGW = gridDim.x * 8;
    for (int m = gw; m < M; m += NGW) { float s = ssq[(size_t)m * 32 + (lane & 31)];
#pragma unroll
        for (int o = 1; o < 32; o <<= 1) s += __shfl_xor(s, o);
        const float rs = __builtin_amdgcn_rsqf(s * (1.0f / D) + 1e-6f); f32x4* xr = (f32x4*)(x + (size_t)m * D) + lane; const f32x4* gr = (const f32x4*)gn + lane;
#pragma unroll
        for (int j = 0; j < 8; ++j) xr[64 * j] = xr[64 * j] * rs * gr[64 * j]; }
}

#define IN(k) (lo <= (k) && (k) < hi)
#define SEAM(k) do { if (IN(k) && IN((k) + 1)) cg::this_grid().sync(); } while (0)
template <int F, int L> __device__ __forceinline__ void ph_ffn_up(const Args& a, LAS unsigned char* lds) {
    unsigned char* ws = a.ws;
    pg8::Gemm g{(const bf16*)(ws + WS_XB0), (const bf16*)(ws + WS_W13 + (size_t)(F * 2 + L) * SZ_W13), M, 2 * FF, D, D}; pg8::StaticOrder S; S.init(M, 2 * FF, gridDim.x, blockIdx.x);
    pg8::EpiSwiGLU E{(bf16*)(ws + WS_BIG), FF, (const float*)(ws + WS_SS0)};
    pg8::gemm_phase<pg8::EpiSwiGLU, pg8::StaticOrder, true, true>(lds, g, S, E);
}
template <int L> __device__ __forceinline__ void ph_ple_proj(const Args& a, LAS unsigned char* lds) {
    unsigned char* ws = a.ws;
    pg8::Gemm g{(const bf16*)(ws + WS_PB) + (size_t)L * M * PLE, (const bf16*)(ws + WS_WP + (size_t)L * SZ_WP), M, D, PLE, PLE}; pg8::StaticOrder S; S.init(M, D, gridDim.x, blockIdx.x);
    pg8::EpiQKV E{(bf16*)(ws + WS_PJ), D, nullptr, nullptr, nullptr, nullptr};
    pg8::gemm_phase<pg8::EpiQKV, pg8::StaticOrder, true, true>(lds, g, S, E);
}
template <int F, int L> __device__ __forceinline__ void ph_ffn_down(const Args& a, LAS unsigned char* lds) {
    unsigned char* ws = a.ws;
    pg8::Gemm g{(const bf16*)(ws + WS_BIG), (const bf16*)(ws + WS_W2 + (size_t)(F * 2 + L) * SZ_W2), M, D, FF, FF}; pg8::StaticOrder S; S.init(M, D, gridDim.x, blockIdx.x);
    pg8::EpiResid E{(F == 0 && L == 0) ? a.in[0] : a.out, a.out, (bf16*)(ws + WS_XB1), (float*)(ws + WS_SS1), nullptr, 0.5f};
    pg8::gemm_phase<pg8::EpiResid, pg8::StaticOrder, true, true>(lds, g, S, E);
}
template <int L> __device__ __forceinline__ void ph_mix_out(const Args& a, LAS unsigned char* lds) {
    unsigned char* ws = a.ws;
    pg8::Gemm g = (L == 0) ? pg8::Gemm{(const bf16*)(ws + WS_BIG), (const bf16*)(ws + WS_WOUT), M, D, GW, 2 * GW}
                           : pg8::Gemm{(const bf16*)(ws + WS_BIG) + (size_t)M * QKVW, (const bf16*)(ws + WS_WO), M, D, D, D};
    pg8::StaticOrder S; S.init(M, D, gridDim.x, blockIdx.x);
    pg8::EpiResid E{a.out, a.out, (bf16*)(ws + WS_XB0), (float*)(ws + WS_SS0), L == 0 ? nullptr : a.in[28], 1.0f};
    pg8::gemm_phase<pg8::EpiResid, pg8::StaticOrder, true, true>(lds, g, S, E);
}
template <int L> __device__ __forceinline__ void ph_mix_in(const Args& a, LAS unsigned char* lds) {
    unsigned char* ws = a.ws;
    if constexpr (L == 0) {
        pg8::Gemm g{(const bf16*)(ws + WS_XB1), (const bf16*)(ws + WS_WIN), M, 2 * GW, D, D}; pg8::StaticOrder S; S.init(M, 2 * GW, gridDim.x, blockIdx.x);
        pg8::EpiGelu E{(bf16*)(ws + WS_BIG), 2 * GW, (const float*)(ws + WS_SS1), (float*)(ws + WS_VSTAT)};
        pg8::gemm_phase<pg8::EpiGelu, pg8::StaticOrder, true, true>(lds, g, S, E);
    } else {
        pg8::Gemm g{(const bf16*)(ws + WS_XB1), (const bf16*)(ws + WS_WQKV), M, QKVW, D, D}; pg8::StaticOrder S; S.init(M, QKVW, gridDim.x, blockIdx.x);
        pg8::EpiQKV E{(bf16*)(ws + WS_BIG), QKVW, (const float*)(ws + WS_SS1), a.in[21], a.in[23], a.in[25]};
        pg8::gemm_phase<pg8::EpiQKV, pg8::StaticOrder, true, true>(lds, g, S, E);
    }
}
template <int L> __device__ __forceinline__ void ph_ple_gate(const Args& a, LAS unsigned char* lds) {
    unsigned char* ws = a.ws;
    pg8::Gemm g{(const bf16*)(ws + WS_XB1), (const bf16*)(ws + WS_WG + (size_t)L * SZ_WG), M, D, D, D}; pg8::StaticOrder S; S.init(M, D, gridDim.x, blockIdx.x);
    pg8::EpiPLE E{a.out, (bf16*)(ws + WS_XB0), (float*)(ws + WS_SS0), (const float*)(ws + WS_SS1), (const bf16*)(ws + WS_PJ)};
    pg8::gemm_phase<pg8::EpiPLE, pg8::StaticOrder, true, true>(lds, g, S, E);
}
template <int L> __device__ __forceinline__ void layer(const Args& a, LAS unsigned char* lds, const int lo, const int hi) {
    constexpr int P = 1 + 8 * L; unsigned char* ws = a.ws;
    if (IN(P + 0)) ph_ffn_up<0, L>(a, lds);
    SEAM(P + 0);
    if (IN(P + 1)) ph_ffn_down<0, L>(a, lds);
    SEAM(P + 1);
    if (IN(P + 2)) ph_mix_in<L>(a, lds);
    SEAM(P + 2);
    if (IN(P + 3)) {
        if constexpr (L == 0) spatial_phase(lds, (bf16*)(ws + WS_BIG), (const float*)(ws + WS_VSTAT), a.in[15], a.in[16], a.in[17], a.in[18]);
        else attn_phase(lds, (const bf16*)(ws + WS_BIG), (bf16*)(ws + WS_BIG) + (size_t)M * QKVW, (const float*)(ws + WS_ROPE), a.in[26]);
    }
    SEAM(P + 3);
    if (IN(P + 4)) ph_mix_out<L>(a, lds);
    SEAM(P + 4);
    if (IN(P + 5)) { ph_ffn_up<1, L>(a, lds); ph_ple_proj<L>(a, lds); }
    SEAM(P + 5);
    if (IN(P + 6)) ph_ffn_down<1, L>(a, lds);
    SEAM(P + 6);
    if (IN(P + 7)) ph_ple_gate<L>(a, lds);
    SEAM(P + 7);
}
__global__ void __launch_bounds__(512, 2) mega_fwd(Args a) {
    extern __shared__ __attribute__((aligned(16))) unsigned char lds_raw[];
    LAS unsigned char* lds = (LAS unsigned char*)lds_raw;
    const int lo = a.lo, hi = a.hi;
    if (IN(0)) p0_prologue(a, lds);
    SEAM(0);
    layer<0>(a, lds, lo, hi);
    layer<1>(a, lds, lo, hi);
    if (IN(NPHASE - 1)) final_phase(a.out, (const float*)(a.ws + WS_SS0), a.in[29]);
}
#undef IN
#undef SEAM

extern "C" void kernel_launch(void* const* d_in, const int* in_sizes, int n_in, void* d_out, int out_size, void* d_ws, size_t ws_size, hipStream_t stream) {
    static int grid = 0;
    if (grid == 0) {
        if (n_in != 30 || in_sizes[0] != M * D || out_size != M * D || ws_size < WS_END) { fprintf(stderr, "kernel_launch: unexpected shapes / workspace (n_in %d, in0 %d, out %d, ws %zu, need %zu)\n", n_in, n_in > 0 ? in_sizes[0] : -1, out_size, ws_size, (size_t)WS_END); grid = -1; return; }
        int dev = 0, cus = 0, per_cu = 0;
        if (hipGetDevice(&dev) != hipSuccess || hipDeviceGetAttribute(&cus, hipDeviceAttributeMultiprocessorCount, dev) != hipSuccess) { grid = -1; return; }
        if (hipFuncSetAttribute((const void*)mega_fwd, hipFuncAttributeMaxDynamicSharedMemorySize, LDS_BYTES) != hipSuccess) { fprintf(stderr, "kernel_launch: hipFuncSetAttribute failed\n"); grid = -1; return; }
        if (hipOccupancyMaxActiveBlocksPerMultiprocessor(&per_cu, (const void*)mega_fwd, 512, LDS_BYTES) != hipSuccess || per_cu < 1) { fprintf(stderr, "kernel_launch: occupancy query says %d blocks per CU\n", per_cu); per_cu = 1; }
        (void)hipGetLastError();
        grid = cus * (per_cu > 1 ? 1 : per_cu);
    }
    if (grid < 0) return;
    Args a{};
    for (int i = 0; i < 30; ++i) a.in[i] = (const float*)d_in[i];
    a.out = (float*)d_out; a.ws = (unsigned char*)d_ws;
    for (int j = 0; j < 8; ++j) a.invf[j] = (float)pow(500000.0, -(double)(2 * j) / 16.0);
#if MK_MULTI
    for (int ph = 0; ph < NPHASE; ++ph) { a.lo = ph; a.hi = ph + 1; hipLaunchKernelGGL(mega_fwd, dim3(grid), dim3(512), LDS_BYTES, stream, a); }
#else
    a.lo = 0; a.hi = NPHASE;
    void* args[] = {&a};
    hipError_t e = hipLaunchCooperativeKernel((const void*)mega_fwd, dim3(grid), dim3(512), args, LDS_BYTES, stream);
    if (e != hipSuccess) fprintf(stderr, "kernel_launch: cooperative launch failed: %s (grid %d)\n", hipGetErrorString(e), grid);
#endif
}
```

```cpp
#include <hip/hip_runtime.h>
#include <cstdio>
#include <cstdint>
#include <cmath>
namespace pg8 {
#define PG8_LAS __attribute__((address_space(3)))
typedef unsigned short bf16_t;
typedef short bf16x8 __attribute__((ext_vector_type(8)));
typedef float f32x4 __attribute__((ext_vector_type(4)));
typedef unsigned u32x4 __attribute__((ext_vector_type(4)));
constexpr int BM = 256, BK = 64, HALF = 128, HTB = HALF * BK * 2  , STAGE_BYTES = 8 * HTB, NXCD = 8, WGM = 8;

__host__ __device__ __forceinline__ int lds_byte(int r, int c) { const int st = (r >> 4) * 2 + (c >> 5), rr = r & 15, cc = c & 31, ob = rr * 64 + cc * 2; return st * 1024 + (ob ^ (((ob >> 9) & 1) << 5)); }
__host__ __device__ __forceinline__ void stage_rc(int b, int& R, int& C) { const int st = b / 1024, sb = b % 1024, swz = sb ^ (((sb >> 9) & 1) << 5); R = (st >> 1) * 16 + swz / 64; C = (st & 1) * 32 + (swz % 64) / 2; }
__host__ __device__ __forceinline__ int perm32(int rho) { const int n = rho >> 4, i = rho & 15; return 8 * (i >> 2) + 4 * n + (i & 3); }

struct Unit { int pm, pn; };
struct Gemm { const bf16_t* A; const bf16_t* Bt; int M, N, K, lda; size_t a_tstep; int a_blk, a_sh; };

struct StaticOrder {
    int nM, nN, nwg, G, c;
    __host__ __device__ void init(int M, int N, int G_, int c_) { nM = M / BM; nN = N / BM; nwg = nM * nN; G = G_; c = c_; }
    __host__ __device__ bool next(int i, Unit& u) const {
        const long L = (long)i * G + c; if (L >= nwg) return false;
        int wgid = (int)L; { const int q = nwg / NXCD, r = nwg % NXCD, xcd = wgid % NXCD, off = wgid / NXCD; wgid = (xcd < r ? xcd * (q + 1) : r * (q + 1) + (xcd - r) * q) + off; }
        const int nig = WGM * nN, gid = wgid / nig, fm = gid * WGM, gsz = (nM - fm) < WGM ? (nM - fm) : WGM;
        u.pm = fm + ((wgid % nig) % gsz); u.pn = (wgid % nig) / gsz; return true;
    }
    __device__ __forceinline__ void a_ready(const Unit&) const {}
    __device__ __forceinline__ void done(const Unit&) const {}
};

__device__ __forceinline__ unsigned cvt_pk_bf16(float lo, float hi) { unsigned r; asm volatile("v_cvt_pk_bf16_f32 %0, %1, %2" : "=v"(r) : "v"(lo), "v"(hi)); return r; }
typedef float f32x2 __attribute__((ext_vector_type(2)));
__device__ __forceinline__ f32x2 gelu_pk(f32x2 v) {
    const f32x2 av = __builtin_elementwise_abs(v), d = av * 0.2316418882f + 1.0f;
    f32x2 t; t.x = __builtin_amdgcn_rcpf(d.x); t.y = __builtin_amdgcn_rcpf(d.y);
    f32x2 q = t * 0.5307027145f + (-0.7265760135f); q = q * t + 0.7107068705f; q = q * t + (-0.142248368f); q = q * t + 0.127414796f; q = q * t;
    const f32x2 s = (v * v) * (-0.72134752044f);
    f32x2 e; e.x = __builtin_amdgcn_exp2f(s.x); e.y = __builtin_amdgcn_exp2f(s.y);
    const f32x2 m = v * (q * e), r = v - m;
    f32x2 o; o.x = v.x < 0.f ? m.x : r.x; o.y = v.y < 0.f ? m.y : r.y; return o;
}
constexpr int XD = 2048;
typedef unsigned u32x2 __attribute__((ext_vector_type(2)));
__device__ __forceinline__ float row_rstd(const float* ssqp, int row, int fq) {
    const f32x4* p = (const f32x4*)(ssqp + (size_t)row * 32 + fq * 8);
    const f32x4 a = p[0], b = p[1];
    float s = ((a[0] + a[1]) + (a[2] + a[3])) + ((b[0] + b[1]) + (b[2] + b[3]));
    s += __shfl_xor(s, 16); s += __shfl_xor(s, 32);
    return __builtin_amdgcn_rsqf(s * (1.0f / 2048.0f) + 1e-6f);
}
__device__ __forceinline__ float tile_rstd(const PG8_LAS float* rsl, const float* ssqp, int row, int fq) { return rsl ? rsl[row & (BM - 1)] : row_rstd(ssqp, row, fq); }
__device__ __forceinline__ float sigmoid_f(float z) { return __builtin_amdgcn_rcpf(1.0f + __builtin_amdgcn_exp2f(z * -1.4426950408889634f)); }
__device__ __forceinline__ u32x4 pack8(const f32x4& v0, const f32x4& v1) { u32x4 w; w.x = cvt_pk_bf16(v0[0], v0[1]); w.y = cvt_pk_bf16(v0[2], v0[3]); w.z = cvt_pk_bf16(v1[0], v1[1]); w.w = cvt_pk_bf16(v1[2], v1[3]); return w; }
__device__ __forceinline__ float bf_lo(unsigned w) { return __uint_as_float(w << 16); }
__device__ __forceinline__ float bf_hi(unsigned w) { return __uint_as_float(w & 0xffff0000u); }

struct EpiSwiGLU {
    static constexpr bool PERM = true, AFTER_DRAIN = false;
    bf16_t* H; size_t pstride; const float* ssqp; const PG8_LAS float* rsl;
    __device__ __forceinline__ void operator()(const f32x4 (&acc)[2][2][4][2], const Unit& u, int wr, int wc, int fr, int fq) const {
        const int row0 = u.pm * BM + wr * 64 + fr, col0 = u.pn * HALF + wc * 32 + 8 * fq;
        float rs[2][4];
#pragma unroll
        for (int ai = 0; ai < 2; ++ai) {
#pragma unroll
            for (int m = 0; m < 4; ++m) rs[ai][m] = tile_rstd(rsl, ssqp, row0 + ai * HALF + m * 16, fq);
            asm volatile("" ::: "memory"); }
        asm volatile("" ::: "memory");
#pragma unroll
        for (int ai = 0; ai < 2; ++ai)
#pragma unroll
            for (int m = 0; m < 4; ++m) { const int row = row0 + ai * HALF + m * 16; const float r = rs[ai][m];
                f32x4 h[2];
#pragma unroll
                for (int n = 0; n < 2; ++n) { const f32x4 a = acc[ai][0][m][n] * r, b = acc[ai][1][m][n] * r;
#pragma unroll
                    for (int e = 0; e < 4; ++e) h[n][e] = a[e] * b[e] * sigmoid_f(a[e]); }
                *(u32x4*)(H + (size_t)u.pm * pstride + (size_t)u.pn * 32768 + (size_t)(wr * 64 + fr + ai * HALF + m * 16) * HALF + wc * 32 + 8 * fq) = pack8(h[0], h[1]); }
    }
};
__device__ __forceinline__ void unpack8(const u32x4& w, f32x4& v0, f32x4& v1) { v0 = (f32x4){bf_lo(w.x), bf_hi(w.x), bf_lo(w.y), bf_hi(w.y)}; v1 = (f32x4){bf_lo(w.z), bf_hi(w.z), bf_lo(w.w), bf_hi(w.w)}; }
template <bool F32IN> struct EpiResid {
    static constexpr bool PERM = true, AFTER_DRAIN = false;
    static constexpr int NB = F32IN ? 2 : 4;
    const float* xin_f; const bf16_t* xin_b; bf16_t* xb; float* ssq_out; const float* bias; float alpha;
    __device__ __forceinline__ void operator()(const f32x4 (&acc)[2][2][4][2], const Unit& u, int wr, int wc, int fr, int fq) const {
        const int row0 = u.pm * BM + wr * 64 + fr, col0 = u.pn * BM + wc * 32 + 8 * fq;
        const size_t tb = (size_t)(u.pm * 8 + u.pn) * 65536 + wc * 32 + 8 * fq; const int rit0 = wr * 64 + fr;
        f32x4 bv[2][2];
#pragma unroll
        for (int bj = 0; bj < 2; ++bj)
#pragma unroll
            for (int n = 0; n < 2; ++n) bv[bj][n] = bias ? *(const f32x4*)(bias + col0 + bj * HALF + 4 * n) : (f32x4){0.f, 0.f, 0.f, 0.f};
#pragma unroll
        for (int ai = 0; ai < 2; ++ai)
#pragma unroll
          for (int mh = 0; mh < 4 / NB; ++mh) {
            f32x4 xv[NB][2][2]; u32x4 xw[NB][2];
#pragma unroll
            for (int mm = 0; mm < NB; ++mm)
#pragma unroll
                for (int bj = 0; bj < 2; ++bj) { const size_t off = (size_t)(row0 + ai * HALF + (NB * mh + mm) * 16) * XD + col0 + bj * HALF;
                    if constexpr (F32IN) { xv[mm][bj][0] = *(const f32x4*)(xin_f + off); xv[mm][bj][1] = *(const f32x4*)(xin_f + off + 4); }
                    else xw[mm][bj] = *(const u32x4*)(xin_b + tb + (size_t)(rit0 + ai * HALF + (NB * mh + mm) * 16) * BM + bj * HALF); }
            asm volatile("" ::: "memory");
#pragma unroll
            for (int mm = 0; mm < NB; ++mm) { const int m = NB * mh + mm; const int row = row0 + ai * HALF + m * 16; const size_t off = (size_t)row * XD + col0; float ss = 0.f;
#pragma unroll
                for (int bj = 0; bj < 2; ++bj) {
                    f32x4 x0, x1; if constexpr (F32IN) { x0 = xv[mm][bj][0]; x1 = xv[mm][bj][1]; } else unpack8(xw[mm][bj], x0, x1);
                    const f32x4 v0 = x0 + acc[ai][bj][m][0] * alpha + bv[bj][0], v1 = x1 + acc[ai][bj][m][1] * alpha + bv[bj][1];
                    *(u32x4*)(xb + tb + (size_t)(rit0 + ai * HALF + m * 16) * BM + bj * HALF) = pack8(v0, v1);
                    ss += (v0[0] * v0[0] + v0[1] * v0[1]) + (v0[2] * v0[2] + v0[3] * v0[3]) + (v1[0] * v1[0] + v1[1] * v1[1]) + (v1[2] * v1[2] + v1[3] * v1[3]); }
                ss += __shfl_xor(ss, 16); ss += __shfl_xor(ss, 32);
                if (fq == 0) ssq_out[(size_t)row * 32 + u.pn * 4 + wc] = ss; }
            asm volatile("" ::: "memory");
          }
    }
};
struct EpiGelu {
    static constexpr bool PERM = true, AFTER_DRAIN = false;
    bf16_t* Z; int ldz; const float* ssqp; float* vstat; const PG8_LAS float* rsl;
    __device__ __forceinline__ void operator()(const f32x4 (&acc)[2][2][4][2], const Unit& u, int wr, int wc, int fr, int fq) const {
        const int row0 = u.pm * BM + wr * 64 + fr, col0 = u.pn * BM + wc * 32 + 8 * fq;
        float rsv[2][4];
#pragma unroll
        for (int ai = 0; ai < 2; ++ai) {
#pragma unroll
            for (int m = 0; m < 4; ++m) rsv[ai][m] = tile_rstd(rsl, ssqp, row0 + ai * HALF + m * 16, fq);
            asm volatile("" ::: "memory"); }
        asm volatile("" ::: "memory");
#pragma unroll
        for (int ai = 0; ai < 2; ++ai)
#pragma unroll
            for (int m = 0; m < 4; ++m) { const int row = row0 + ai * HALF + m * 16; const float rs = rsv[ai][m]; float s1 = 0.f, s2 = 0.f;
#pragma unroll
                for (int bj = 0; bj < 2; ++bj) { f32x4 v0 = acc[ai][bj][m][0] * rs, v1 = acc[ai][bj][m][1] * rs;
                    const f32x2 a = gelu_pk((f32x2){v0[0], v0[1]}), b = gelu_pk((f32x2){v0[2], v0[3]}), c = gelu_pk((f32x2){v1[0], v1[1]}), d = gelu_pk((f32x2){v1[2], v1[3]});
                    v0 = (f32x4){a.x, a.y, b.x, b.y}; v1 = (f32x4){c.x, c.y, d.x, d.y};
                    *(u32x4*)(Z + (size_t)u.pm * 2097152 + (size_t)u.pn * 65536 + (size_t)(wr * 64 + fr + ai * HALF + m * 16) * BM + wc * 32 + 8 * fq + bj * HALF) = pack8(v0, v1);
                    s1 += ((v0[0] + v0[1]) + (v0[2] + v0[3])) + ((v1[0] + v1[1]) + (v1[2] + v1[3]));
                    s2 += (v0[0] * v0[0] + v0[1] * v0[1]) + (v0[2] * v0[2] + v0[3] * v0[3]) + (v1[0] * v1[0] + v1[1] * v1[1]) + (v1[2] * v1[2] + v1[3] * v1[3]); }
                if (u.pn >= 16) { s1 += __shfl_xor(s1, 16); s1 += __shfl_xor(s1, 32); s2 += __shfl_xor(s2, 16); s2 += __shfl_xor(s2, 32);
                    if (fq == 0) *(f32x2*)(vstat + ((size_t)row * 64 + (u.pn - 16) * 4 + wc) * 2) = (f32x2){s1, s2}; } }
    }
};
struct EpiQKV {
    static constexpr bool PERM = true, AFTER_DRAIN = false;
    bf16_t* O; int ldo; const float* ssqp; const float* bq; const float* bk; const float* bv; const PG8_LAS float* rsl;
    __device__ __forceinline__ void operator()(const f32x4 (&acc)[2][2][4][2], const Unit& u, int wr, int wc, int fr, int fq) const {
        const int row0 = u.pm * BM + wr * 64 + fr, cin = wc * 32 + 8 * fq, col0 = u.pn * BM + cin;
        const float* bp = bq ? (u.pn < 8 ? bq + u.pn * BM : (u.pn == 8 ? bk : bv)) + cin : nullptr;
        f32x4 bvv[2][2];
#pragma unroll
        for (int bj = 0; bj < 2; ++bj)
#pragma unroll
            for (int n = 0; n < 2; ++n) bvv[bj][n] = bp ? *(const f32x4*)(bp + bj * HALF + 4 * n) : (f32x4){0.f, 0.f, 0.f, 0.f};
#pragma unroll
        for (int ai = 0; ai < 2; ++ai) {
            float rsv[4];
#pragma unroll
            for (int m = 0; m < 4; ++m) rsv[m] = ssqp ? tile_rstd(rsl, ssqp, row0 + ai * HALF + m * 16, fq) : 1.0f;
            asm volatile("" ::: "memory");
#pragma unroll
            for (int m = 0; m < 4; ++m) { const int row = row0 + ai * HALF + m * 16; const float rs = rsv[m];
#pragma unroll
                for (int bj = 0; bj < 2; ++bj) *(u32x4*)(O + (size_t)row * ldo + col0 + bj * HALF) = pack8(acc[ai][bj][m][0] * rs + bvv[bj][0], acc[ai][bj][m][1] * rs + bvv[bj][1]); }
            asm volatile("" ::: "memory");
        }
    }
};
template <bool LAST> struct EpiPLE {
    static constexpr bool PERM = true, AFTER_DRAIN = false;
    const bf16_t* xin_b; float* xout_f; bf16_t* xb; float* ssq_out; const float* ssqp; const bf16_t* pj; const PG8_LAS float* rsl;
    __device__ __forceinline__ void operator()(const f32x4 (&acc)[2][2][4][2], const Unit& u, int wr, int wc, int fr, int fq) const {
        const int row0 = u.pm * BM + wr * 64 + fr, col0 = u.pn * BM + wc * 32 + 8 * fq;
        const size_t tb = (size_t)(u.pm * 8 + u.pn) * 65536 + wc * 32 + 8 * fq; const int rit0 = wr * 64 + fr;
#pragma unroll
        for (int ai = 0; ai < 2; ++ai)
#pragma unroll
            for (int mh = 0; mh < 2; ++mh) {
                float rsv[2];
#pragma unroll
                for (int mm = 0; mm < 2; ++mm) rsv[mm] = tile_rstd(rsl, ssqp, row0 + ai * HALF + (2 * mh + mm) * 16, fq);
                u32x4 xw[2][2], pv[2][2];
#pragma unroll
                for (int mm = 0; mm < 2; ++mm)
#pragma unroll
                    for (int bj = 0; bj < 2; ++bj) { const size_t off = (size_t)(row0 + ai * HALF + (2 * mh + mm) * 16) * XD + col0 + bj * HALF; xw[mm][bj] = *(const u32x4*)(xin_b + tb + (size_t)(rit0 + ai * HALF + (2 * mh + mm) * 16) * BM + bj * HALF); pv[mm][bj] = *(const u32x4*)(pj + off); }
                asm volatile("" ::: "memory");
#pragma unroll
                for (int mm = 0; mm < 2; ++mm) { const int m = 2 * mh + mm; const int row = row0 + ai * HALF + m * 16; const size_t off = (size_t)row * XD + col0; const float rs = rsv[mm]; float ss = 0.f;
#pragma unroll
                    for (int bj = 0; bj < 2; ++bj) { f32x4 x0, x1, p0, p1; unpack8(xw[mm][bj], x0, x1); unpack8(pv[mm][bj], p0, p1);
                        f32x4 v0, v1;
#pragma unroll
                        for (int e = 0; e < 4; ++e) { v0[e] = x0[e] + sigmoid_f(acc[ai][bj][m][0][e] * rs) * p0[e]; v1[e] = x1[e] + sigmoid_f(acc[ai][bj][m][1][e] * rs) * p1[e]; }
                        if constexpr (LAST) { *(f32x4*)(xout_f + off + bj * HALF) = v0; *(f32x4*)(xout_f + off + bj * HALF + 4) = v1; }
                        else *(u32x4*)(xb + tb + (size_t)(rit0 + ai * HALF + m * 16) * BM + bj * HALF) = pack8(v0, v1);
                        ss += (v0[0] * v0[0] + v0[1] * v0[1]) + (v0[2] * v0[2] + v0[3] * v0[3]) + (v1[0] * v1[0] + v1[1] * v1[1]) + (v1[2] * v1[2] + v1[3] * v1[3]); }
                    ss += __shfl_xor(ss, 16); ss += __shfl_xor(ss, 32);
                    if (fq == 0) ssq_out[(size_t)row * 32 + u.pn * 4 + wc] = ss; }
                asm volatile("" ::: "memory");
            }
    }
};

template <class Epi, class Sched, bool ALIGN_EPI = false, bool SP2 = false>
__device__ __forceinline__ void gemm_phase(PG8_LAS unsigned char* lds, const Gemm g, const Sched& S, const Epi& E) {
    const int tid = threadIdx.x, wid = __builtin_amdgcn_readfirstlane(tid >> 6), lane = tid & 63, wr = wid >> 2, wc = wid & 3, fr = lane & 15, fq = lane >> 4;
    const int K = g.K, nt = K / BK;
    unsigned voffA[2], voffB[2];
#pragma unroll
    for (int i = 0; i < 2; ++i) { int R, C; stage_rc(tid * 16 + i * 8192, R, C); const int Rb = Epi::PERM ? ((R & ~31) + perm32(R & 31)) : R;
        voffA[i] = (unsigned)(R * g.lda + C) * 2u; voffB[i] = (unsigned)(Rb * K + C) * 2u; }
    const size_t kstep = (size_t)(BK * 2);
    const size_t hstepA = (size_t)HALF * g.lda * 2, hstepB = (size_t)HALF * K * 2;
    const size_t tstepA = g.a_tstep ? g.a_tstep : 2 * hstepA, tstepB = 2 * hstepB;
    const unsigned ldsw = (unsigned)wid * 1024u;
    const int aoff = lds_byte(wr * 64 + fr, fq * 8), boff = lds_byte(wc * 32 + fr, fq * 8);
#define PG8_SA(b, h) (((b) * 2 + (h)) * HTB)
#define PG8_SB(b, h) ((4 + (b) * 2 + (h)) * HTB)
#define PG8_STAGE(bufoff, gbase, voff) do { _Pragma("unroll") for (int _i = 0; _i < 2; ++_i) \
        __builtin_amdgcn_global_load_lds((const unsigned*)((const char*)(gbase) + (voff)[_i]), (PG8_LAS unsigned*)(lds + (bufoff) + ldsw + _i * 8192), 16, 0, 0); } while (0)
#define PG8_LDA(dst, b, h) do { _Pragma("unroll") for (int m = 0; m < 4; ++m) _Pragma("unroll") for (int k = 0; k < 2; ++k) dst[m][k] = *(const PG8_LAS bf16x8*)(lds + PG8_SA(b, h) + aoff + m * 2048 + k * 1024); } while (0)
#define PG8_LDB(dst, b, h) do { _Pragma("unroll") for (int n = 0; n < 2; ++n) _Pragma("unroll") for (int k = 0; k < 2; ++k) dst[n][k] = *(const PG8_LAS bf16x8*)(lds + PG8_SB(b, h) + boff + n * 2048 + k * 1024); } while (0)
#define PG8_MMA(ai, bj, At, Bt) do { __builtin_amdgcn_s_setprio(1); _Pragma("unroll") for (int m = 0; m < 4; ++m) _Pragma("unroll") for (int n = 0; n < 2; ++n) _Pragma("unroll") for (int k = 0; k < 2; ++k) \
        acc[ai][bj][m][n] = __builtin_amdgcn_mfma_f32_16x16x32_bf16(Bt[n][k], At[m][k], acc[ai][bj][m][n], 0, 0, 0); __builtin_amdgcn_s_setprio(0); } while (0)
#define PG8_WAIT_V(n) asm volatile("s_waitcnt vmcnt(" #n ")" ::: "memory")
#define PG8_WAIT_L(n) asm volatile("s_waitcnt lgkmcnt(" #n ")" ::: "memory")
#define PG8_BAR __builtin_amdgcn_s_barrier()
#define PG8_SCHED __builtin_amdgcn_sched_barrier(0)
    Unit cur, nxt; int ui = 0;
    if (!S.next(0, cur)) return;
    f32x4 acc[2][2][4][2];
#pragma unroll
    for (int a = 0; a < 2; ++a)
#pragma unroll
        for (int b = 0; b < 2; ++b)
#pragma unroll
            for (int m = 0; m < 4; ++m)
#pragma unroll
                for (int n = 0; n < 2; ++n) acc[a][b][m][n] = (f32x4){0.f, 0.f, 0.f, 0.f};
    bf16x8 At[4][2], B0[2][2], B1[2][2];
    const char* cA = (const char*)g.A + (size_t)cur.pm * tstepA; const char* cB = (const char*)g.Bt + (size_t)cur.pn * tstepB;
    S.a_ready(cur);
    if constexpr (SP2) {
        PG8_STAGE(PG8_SB(0, 0), cB, voffB); PG8_STAGE(PG8_SB(0, 1), cB + hstepB, voffB); PG8_STAGE(PG8_SA(0, 0), cA, voffA); PG8_STAGE(PG8_SA(0, 1), cA + hstepA, voffA);
        if (wr == 1) PG8_BAR;
        PG8_WAIT_V(2); PG8_BAR;
        PG8_STAGE(PG8_SB(1, 0), cB + kstep, voffB); PG8_STAGE(PG8_SA(1, 0), cA + kstep, voffA); PG8_STAGE(PG8_SB(1, 1), cB + hstepB + kstep, voffB);
        PG8_WAIT_V(6); PG8_BAR;
    } else {
        PG8_STAGE(PG8_SB(0, 0), cB, voffB); PG8_STAGE(PG8_SA(0, 0), cA, voffA); PG8_STAGE(PG8_SB(0, 1), cB + hstepB, voffB); PG8_STAGE(PG8_SA(0, 1), cA + hstepA, voffA);
        if (wr == 1) PG8_BAR;
        PG8_WAIT_V(4); PG8_BAR;
        PG8_STAGE(PG8_SB(1, 0), cB + kstep, voffB); PG8_STAGE(PG8_SA(1, 0), cA + kstep, voffA); PG8_STAGE(PG8_SB(1, 1), cB + hstepB + kstep, voffB);
        PG8_WAIT_V(6); PG8_BAR;
    }
    for (;;) {
        const bool has_next = S.next(ui + 1, nxt);
        const char* nA = has_next ? (const char*)g.A + (size_t)nxt.pm * tstepA : cA; const char* nB = has_next ? (const char*)g.Bt + (size_t)nxt.pn * tstepB : cB;
        for (int t = 0; t < nt; t += 2) {
            const bool last = (t == nt - 2);
#define PG8_KOFFA(tt) (g.a_blk ? (size_t)((tt) >> g.a_sh) * (size_t)g.a_blk + (size_t)((tt) & ((1 << g.a_sh) - 1)) * kstep : (size_t)(tt) * kstep)
            const char* a1 = cA + PG8_KOFFA(t + 1);
            const char* a2 = last ? nA : cA + PG8_KOFFA(t + 2); const char* b2 = last ? nB : cB + (size_t)(t + 2) * kstep;
            const char* a3 = last ? nA + kstep : cA + PG8_KOFFA(t + 3); const char* b3 = b2 + kstep;
#undef PG8_KOFFA
            if (last && has_next) S.a_ready(nxt);
            if constexpr (SP2) {
            PG8_LDB(B0, 0, 0); PG8_LDB(B1, 0, 1); PG8_SCHED; PG8_LDA(At, 0, 0); PG8_STAGE(PG8_SA(1, 1), a1 + hstepA, voffA);
            PG8_WAIT_V(8); PG8_WAIT_L(0); PG8_BAR; PG8_MMA(0, 0, At, B0); PG8_MMA(0, 1, At, B1); PG8_BAR; PG8_SCHED;
            PG8_LDA(At, 0, 1); PG8_STAGE(PG8_SB(0, 0), b2, voffB); PG8_STAGE(PG8_SB(0, 1), b2 + hstepB, voffB); PG8_STAGE(PG8_SA(0, 0), a2, voffA);
            PG8_WAIT_V(8); PG8_WAIT_L(0); PG8_BAR; PG8_MMA(1, 0, At, B0); PG8_MMA(1, 1, At, B1); PG8_BAR; PG8_SCHED;
            PG8_LDB(B0, 1, 0); PG8_LDB(B1, 1, 1); PG8_SCHED; PG8_LDA(At, 1, 0); PG8_STAGE(PG8_SA(0, 1), a2 + hstepA, voffA);
            PG8_WAIT_V(8); PG8_WAIT_L(0); PG8_BAR; PG8_MMA(0, 0, At, B0); PG8_MMA(0, 1, At, B1); PG8_BAR; PG8_SCHED;
            PG8_LDA(At, 1, 1); PG8_STAGE(PG8_SB(1, 0), b3, voffB); PG8_STAGE(PG8_SB(1, 1), b3 + hstepB, voffB); PG8_STAGE(PG8_SA(1, 0), a3, voffA);
            PG8_WAIT_V(8); PG8_WAIT_L(0); PG8_BAR; PG8_MMA(1, 0, At, B0); PG8_MMA(1, 1, At, B1); PG8_BAR; PG8_SCHED;
            } else {
            PG8_LDB(B0, 0, 0); PG8_SCHED; PG8_LDA(At, 0, 0); PG8_STAGE(PG8_SA(1, 1), a1 + hstepA, voffA);
            PG8_WAIT_L(8); PG8_BAR; PG8_WAIT_L(0); PG8_MMA(0, 0, At, B0); PG8_BAR; PG8_SCHED;
            PG8_LDB(B1, 0, 1); PG8_STAGE(PG8_SB(0, 0), b2, voffB);
            PG8_BAR; PG8_WAIT_L(0); PG8_MMA(0, 1, At, B1); PG8_BAR;
            PG8_LDA(At, 0, 1); PG8_STAGE(PG8_SA(0, 0), a2, voffA);
            PG8_BAR; PG8_WAIT_L(0); PG8_MMA(1, 0, At, B0); PG8_BAR; PG8_SCHED;
            PG8_STAGE(PG8_SB(0, 1), b2 + hstepB, voffB);
            PG8_WAIT_V(6); PG8_BAR; PG8_MMA(1, 1, At, B1); PG8_BAR;
            PG8_LDB(B0, 1, 0); PG8_SCHED; PG8_LDA(At, 1, 0); PG8_STAGE(PG8_SA(0, 1), a2 + hstepA, voffA);
            PG8_WAIT_L(8); PG8_BAR; PG8_WAIT_L(0); PG8_MMA(0, 0, At, B0); PG8_BAR; PG8_SCHED;
            PG8_LDB(B1, 1, 1); PG8_STAGE(PG8_SB(1, 0), b3, voffB);
            PG8_BAR; PG8_WAIT_L(0); PG8_MMA(0, 1, At, B1); PG8_BAR;
            PG8_LDA(At, 1, 1); PG8_STAGE(PG8_SA(1, 0), a3, voffA);
            PG8_BAR; PG8_WAIT_L(0); PG8_MMA(1, 0, At, B0); PG8_BAR; PG8_SCHED;
            PG8_STAGE(PG8_SB(1, 1), b3 + hstepB, voffB);
            PG8_WAIT_V(6); PG8_BAR; PG8_MMA(1, 1, At, B1); PG8_BAR;
            }
        }
        if constexpr (ALIGN_EPI) { if (wr == 0) PG8_BAR; }
        if constexpr (!Epi::AFTER_DRAIN) { E(acc, cur, wr, wc, fr, fq); S.done(cur); }
        if (!has_next) break;
#pragma unroll
        for (int a = 0; a < 2; ++a)
#pragma unroll
            for (int b = 0; b < 2; ++b)
#pragma unroll
                for (int m = 0; m < 4; ++m)
#pragma unroll
                    for (int n = 0; n < 2; ++n) acc[a][b][m][n] = (f32x4){0.f, 0.f, 0.f, 0.f};
        cur = nxt; cA = nA; cB = nB; ++ui;
        if constexpr (ALIGN_EPI) { if (wr == 1) PG8_BAR; }
    }
    PG8_WAIT_V(0);
    if constexpr (!ALIGN_EPI) { if (wr == 0) PG8_BAR; }
    PG8_BAR;
    if constexpr (Epi::AFTER_DRAIN) { E.fused(acc, cur, wr, wc, fr, fq, lds, wid, lane); S.done(cur); }
#undef PG8_SA
#undef PG8_SB
#undef PG8_STAGE
#undef PG8_LDA
#undef PG8_LDB
#undef PG8_MMA
#undef PG8_WAIT_V
#undef PG8_WAIT_L
#undef PG8_BAR
#undef PG8_SCHED
}
}
#include <hip/hip_cooperative_groups.h>
namespace cg = cooperative_groups;
#ifndef MK_MULTI
#define MK_MULTI 0
#endif
#define LAS __attribute__((address_space(3)))
typedef unsigned short bf16;
typedef float f32x4 __attribute__((ext_vector_type(4)));
typedef float f32x2 __attribute__((ext_vector_type(2)));
typedef unsigned u32x4 __attribute__((ext_vector_type(4)));
typedef unsigned u32x2 __attribute__((ext_vector_type(2)));
typedef short bf16x8 __attribute__((ext_vector_type(8)));
typedef short s16x4 __attribute__((ext_vector_type(4)));

constexpr int BATCH = 4, SEQ = 4096, M = BATCH * SEQ, D = 2048, FF = 5632, PLE = 256, GW = 4096, NQH = 32, NKV = 4, HD = 64, QKVW = 2560;
constexpr int NPHASE = 18;
constexpr size_t MiB = 1u << 20;
constexpr size_t WS_ROPE = 1 * MiB, WS_SS0 = 2 * MiB, WS_SS1 = 4 * MiB, WS_VSTAT = 6 * MiB, WS_PB = 16 * MiB, WS_XB0 = 32 * MiB, WS_XB1 = 96 * MiB, WS_PJ = 160 * MiB, WS_BIG = 224 * MiB;
constexpr size_t WS_W13 = 480 * MiB, SZ_W13 = (size_t)2 * FF * D * 2;
constexpr size_t WS_W2 = WS_W13 + 4 * SZ_W13, SZ_W2 = (size_t)D * FF * 2;
constexpr size_t WS_WG = WS_W2 + 4 * SZ_W2, SZ_WG = (size_t)D * D * 2;
constexpr size_t WS_WP = WS_WG + 2 * SZ_WG, SZ_WP = (size_t)D * PLE * 2;
constexpr size_t WS_WIN = WS_WP + 2 * SZ_WP, WS_WOUT = WS_WIN + (size_t)2 * GW * D * 2, WS_WQKV = WS_WOUT + (size_t)D * GW * 2, WS_WO = WS_WQKV + (size_t)QKVW * D * 2, WS_END = WS_WO + (size_t)D * D * 2;
constexpr int LDS_BYTES = 135168;
constexpr int MISC_OFF = 131072;
constexpr size_t WS_CTL = 0;

__device__ __forceinline__ unsigned f2bf(float f) { unsigned u = __builtin_bit_cast(unsigned, f); return (u + 0x7fffu + ((u >> 16) & 1u)) >> 16; }
__device__ __forceinline__ unsigned pk2(float lo, float hi) { return f2bf(lo) | (f2bf(hi) << 16); }
__device__ __forceinline__ float bflo(unsigned w) { return __uint_as_float(w << 16); }
__device__ __forceinline__ float bfhi(unsigned w) { return __uint_as_float(w & 0xffff0000u); }
__device__ __forceinline__ float wave_sum(float v) {
#pragma unroll
    for (int o = 1; o < 64; o <<= 1) v += __shfl_xor(v, o);
    return v;
}
#define LDS_WAIT() asm volatile("s_waitcnt lgkmcnt(0)" ::: "memory")

struct Args { const float* in[30]; float* out; unsigned char* ws; float invf[8]; int lo, hi; };

struct CvDesc { const float* src; bf16* dst; const float* gain; int K, N, mode, off, r; };
__device__ __forceinline__ void cv_load(const CvDesc& d, int lane, f32x4 (&v)[16], f32x4& g0, f32x4& g1) {
    const int nblk = d.N / 64, kb = d.r / nblk, nb = d.r % nblk, k0 = 64 * kb, n0 = 64 * nb;
    const int lk = lane >> 4, n4 = (lane & 15) * 4, c = lane & 7;
#pragma unroll
    for (int j = 0; j < 16; ++j) v[j] = __builtin_nontemporal_load((const f32x4*)(d.src + (size_t)(k0 + 4 * j + lk) * d.N + n0 + n4));
    g0 = (f32x4){1.f, 1.f, 1.f, 1.f}; g1 = g0;
    if (d.gain) { g0 = *(const f32x4*)(d.gain + k0 + 8 * c); g1 = *(const f32x4*)(d.gain + k0 + 8 * c + 4); }
}
__device__ __forceinline__ void cv_process(const CvDesc& d, int lane, const f32x4 (&v)[16], const f32x4& g0, const f32x4& g1, LAS float* scr) {
    const int nblk = d.N / 64, kb = d.r / nblk, nb = d.r % nblk, k0 = 64 * kb, n0 = 64 * nb;
    const int lk = lane >> 4, n4 = (lane & 15) * 4, c = lane & 7;
#pragma unroll
    for (int j = 0; j < 16; ++j) { const int k = 4 * j + lk; *(LAS f32x4*)(scr + k * 64 + (n4 ^ (8 * ((k >> 3) & 7)))) = v[j]; }
    LDS_WAIT(); asm volatile("" ::: "memory");
#pragma unroll
    for (int j = 0; j < 8; ++j) { const int n = (lane >> 3) + 8 * j; const LAS float* s = scr + (8 * c) * 64 + (n ^ (8 * c));
        u32x4 o; o.x = pk2(s[0 * 64] * g0[0], s[1 * 64] * g0[1]); o.y = pk2(s[2 * 64] * g0[2], s[3 * 64] * g0[3]); o.z = pk2(s[4 * 64] * g1[0], s[5 * 64] * g1[1]); o.w = pk2(s[6 * 64] * g1[2], s[7 * 64] * g1[3]);
        const int ng = n0 + n, drow = d.mode ? (((ng >> 7) << 8) + (ng & 127) + d.off) : (d.off + ng);
        *(u32x4*)(d.dst + (size_t)drow * d.K + k0 + 8 * c) = o; }
    LDS_WAIT(); asm volatile("" ::: "memory");
}
constexpr int CV_UP = (D / 64) * (FF / 64), CV_DN = (FF / 64) * (D / 64), CV_DD = (D / 64) * (D / 64), CV_PJ = (PLE / 64) * (D / 64), CV_IN = (D / 64) * (2 * GW / 64), CV_OUT = (GW / 64) * (D / 64), CV_KV = (D / 64) * (256 / 64);
constexpr int CV_LAYER = 4 * CV_UP + 2 * CV_DN + CV_DD + CV_PJ;
constexpr int CV_EARLY = CV_LAYER + 2 * CV_UP + CV_DN + CV_IN + CV_OUT + CV_DD + 2 * CV_KV;
constexpr int CV_ALL = 2 * CV_LAYER + CV_IN + CV_OUT + 2 * CV_DD + 2 * CV_KV;
__device__ __forceinline__ CvDesc cv_decode(const Args& a, int it) {
    unsigned char* ws = a.ws;
    int r = it; CvDesc d; d.src = nullptr; d.dst = nullptr; d.gain = nullptr; d.K = 64; d.N = 64; d.mode = 0; d.off = 0; d.r = 0; bool hit = false;
#define JOB(CNT, SRC, KK, NN, DST, GAIN, MODE, OFF) if (!hit) { if (r < (CNT)) { d.src = (SRC); d.K = (KK); d.N = (NN); d.dst = (bf16*)(DST); d.gain = (GAIN); d.mode = (MODE); d.off = (OFF); d.r = r; hit = true; } else r -= (CNT); }
#define FFN_JOBS(F, L, IW1, IW3, IW2, INORM) \
    JOB(CV_UP, a.in[IW1] + (size_t)(L) * D * FF, D, FF, ws + WS_W13 + (size_t)((F) * 2 + (L)) * SZ_W13, a.in[INORM] + (L) * D, 1, 0) \
    JOB(CV_UP, a.in[IW3] + (size_t)(L) * D * FF, D, FF, ws + WS_W13 + (size_t)((F) * 2 + (L)) * SZ_W13, a.in[INORM] + (L) * D, 1, 128) \
    JOB(CV_DN, a.in[IW2] + (size_t)(L) * D * FF, FF, D, ws + WS_W2 + (size_t)((F) * 2 + (L)) * SZ_W2, nullptr, 0, 0)
#define PLE_JOBS(L) \
    JOB(CV_DD, a.in[12] + (size_t)(L) * D * D, D, D, ws + WS_WG + (size_t)(L) * SZ_WG, a.in[11] + (L) * D, 0, 0) \
    JOB(CV_PJ, a.in[13] + (size_t)(L) * PLE * D, PLE, D, ws + WS_WP + (size_t)(L) * SZ_WP, nullptr, 0, 0)
    FFN_JOBS(0, 0, 3, 4, 5, 2) FFN_JOBS(1, 0, 8, 9, 10, 7) PLE_JOBS(0)
    FFN_JOBS(0, 1, 3, 4, 5, 2)
    JOB(CV_IN, a.in[14], D, 2 * GW, ws + WS_WIN, a.in[6], 0, 0)
    JOB(CV_OUT, a.in[19], GW, D, ws + WS_WOUT, nullptr, 0, 0)
    JOB(CV_DD, a.in[20], D, D, ws + WS_WQKV, a.in[6] + D, 0, 0)
    JOB(CV_KV, a.in[22], D, 256, ws + WS_WQKV, a.in[6] + D, 0, 2048)
    JOB(CV_KV, a.in[24], D, 256, ws + WS_WQKV, a.in[6] + D, 0, 2304)
    FFN_JOBS(1, 1, 8, 9, 10, 7) PLE_JOBS(1)
    JOB(CV_DD, a.in[27], D, D, ws + WS_WO, nullptr, 0, 0)
#undef PLE_JOBS
#undef FFN_JOBS
#undef JOB
    return d;
}
__device__ __forceinline__ void convert_items(const Args& a, LAS unsigned char* lds, int first, int last, int worker, int nworkers) {
    const int tid = threadIdx.x, lane = tid & 63, wave = tid >> 6;
    LAS float* scr = (LAS float*)(lds + wave * 16384);
    int it = first + worker; if (it >= last) return;
    CvDesc d0 = cv_decode(a, it), d1 = d0; f32x4 va[16], vb[16], ga0, ga1, gb0, gb1;
    cv_load(d0, lane, va, ga0, ga1);
    for (;;) {
        const int it1 = it + nworkers; const bool h1 = it1 < last;
        if (h1) { d1 = cv_decode(a, it1); cv_load(d1, lane, vb, gb0, gb1); }
        cv_process(d0, lane, va, ga0, ga1, scr);
        if (!h1) break;
        const int it2 = it1 + nworkers; const bool h2 = it2 < last;
        if (h2) { d0 = cv_decode(a, it2); cv_load(d0, lane, va, ga0, ga1); }
        cv_process(d1, lane, vb, gb0, gb1, scr);
        if (!h2) break;
        it = it2;
    }
}
__device__ __forceinline__ void p0_prologue(const Args& a, LAS unsigned char* lds) {
    const int tid = threadIdx.x, lane = tid & 63, wave = tid >> 6, G = gridDim.x;
    const int gw = blockIdx.x * 8 + wave, NGW = G * 8;
    unsigned char* ws = a.ws;
    convert_items(a, lds, 0, CV_ALL, gw, NGW);
    { const float* x = a.in[0]; bf16* xb = (bf16*)(ws + WS_XB0); float* ss0 = (float*)(ws + WS_SS0);
      for (int m = gw; m < M; m += NGW) { const f32x4* xr = (const f32x4*)(x + (size_t)m * D) + lane; u32x2* o8 = (u32x2*)(xb + (size_t)(m >> 8) * 8 * 65536 + (size_t)(m & 255) * 256) + lane; float s = 0.f;
#pragma unroll
          for (int j = 0; j < 8; ++j) { const f32x4 v = __builtin_nontemporal_load(xr + 64 * j); s += (v[0] * v[0] + v[1] * v[1]) + (v[2] * v[2] + v[3] * v[3]); u32x2 w; w.x = pk2(v[0], v[1]); w.y = pk2(v[2], v[3]); o8[(size_t)j * (65536 / 4)] = w; }
          s = wave_sum(s); if (lane < 32) ss0[(size_t)m * 32 + lane] = lane == 0 ? s : 0.f; } }
    { const float* p = a.in[1]; bf16* pb = (bf16*)(ws + WS_PB); const size_t n8 = (size_t)2 * M * PLE / 8;
      for (size_t i = (size_t)blockIdx.x * 512 + tid; i < n8; i += (size_t)G * 512) { const f32x4 v0 = *(const f32x4*)(p + i * 8), v1 = *(const f32x4*)(p + i * 8 + 4);
          u32x4 w; w.x = pk2(v0[0], v0[1]); w.y = pk2(v0[2], v0[3]); w.z = pk2(v1[0], v1[1]); w.w = pk2(v1[2], v1[3]); *(u32x4*)(pb + i * 8) = w; } }
    { f32x2* rt = (f32x2*)(ws + WS_ROPE);
      for (int i = blockIdx.x * 512 + tid; i < SEQ * 8; i += G * 512) { const int pos = i >> 3, j = i & 7;
          const float ang = __fmul_rn((float)pos, a.invf[j]); const double rev = (double)ang * 0.15915494309189535; const float fr = (float)(rev - __builtin_rint(rev));
          rt[i] = (f32x2){__builtin_amdgcn_cosf(fr), __builtin_amdgcn_sinf(fr)}; } }
}

__device__ __forceinline__ s16x4 tr_read(const LAS bf16* p) { return __builtin_bit_cast(s16x4, __builtin_amdgcn_ds_read_tr16_b64_v4i16((LAS s16x4*)p)); }

#define XB_TMO      128
#define XB_XCNT(j)  (256  + 64 * (j))
#define XB_XSUB(j)  (1280 + 64 * (j))
#define XB_XGEN(j)  (2304 + 64 * (j))
#define XB_TOP      3328
#define XB_TOPGEN   3392
#define XCD_BAR_WORDS 3456
#define XB_SPIN_CAP (1u << 18)

__device__ __forceinline__ unsigned xb_ld(unsigned* p)              { return __hip_atomic_load(p, __ATOMIC_RELAXED, __HIP_MEMORY_SCOPE_AGENT); }
__device__ __forceinline__ unsigned xb_add(unsigned* p, unsigned v) { return __hip_atomic_fetch_add(p, v, __ATOMIC_RELAXED, __HIP_MEMORY_SCOPE_AGENT); }
__device__ __forceinline__ unsigned xb_xcc_id() { return (unsigned)__builtin_amdgcn_s_getreg((3 << 11) | 20) & 0xFu; }
#define XB_SPIN(cond, bar) do { unsigned _sp = 0; while (cond) { __builtin_amdgcn_s_sleep(1); \
    if ((++_sp & 255u) == 0u) { if (xb_ld(&(bar)[XB_TMO])) break; if (_sp > XB_SPIN_CAP) { atomicAdd(&(bar)[XB_TMO], 1u); break; } } } } while (0)

struct XcdBarrier {
    unsigned* bar; unsigned x;
    volatile LAS unsigned* st;
};

__device__ __forceinline__ XcdBarrier xcd_barrier_post(unsigned* bar, volatile LAS unsigned* st) {
    XcdBarrier b; b.bar = bar; b.x = xb_xcc_id(); b.st = st;
    if (threadIdx.x == 0) (void)xb_add(&bar[XB_XCNT(b.x)], 1u);
    return b;
}
__device__ __forceinline__ void xcd_barrier_complete(unsigned* bar, unsigned x, unsigned& nloc, unsigned& nx) {
    const unsigned G = gridDim.x * gridDim.y * gridDim.z;
    unsigned sum, cnt, mine, sp = 0u;
    for (;;) {
        sum = 0u; cnt = 0u; mine = 0u;
#pragma unroll
        for (unsigned j = 0; j < 16; ++j) { const unsigned c = xb_ld(&bar[XB_XCNT(j)]); sum += c; cnt += (c > 0u) ? 1u : 0u; mine = (j == x) ? c : mine; }
        if (sum == G) break;
        __builtin_amdgcn_s_sleep(1);
        if ((++sp & 255u) == 0u) { if (xb_ld(&bar[XB_TMO])) break; if (sp > XB_SPIN_CAP) { atomicAdd(&bar[XB_TMO], 1u); break; } }
    }
    nloc = mine > 0u ? mine : 1u; nx = cnt > 0u ? cnt : 1u;
}

__device__ __forceinline__ void xcd_barrier(const XcdBarrier& b) {
    asm volatile("s_waitcnt vmcnt(0)" ::: "memory");
    __syncthreads();
    if (threadIdx.x == 0) {
        unsigned* bar = b.bar;
        __builtin_amdgcn_s_waitcnt(0);
        unsigned nloc = b.st[0], nx = b.st[1];
        if (nloc == 0u) { xcd_barrier_complete(bar, b.x, nloc, nx); b.st[0] = nloc; b.st[1] = nx; }
        const unsigned old = xb_add(&bar[XB_XSUB(b.x)], 1u);
        const unsigned gen = old / nloc;
        if (old + 1u == (gen + 1u) * nloc) {
            __builtin_amdgcn_fence(__ATOMIC_RELEASE, "agent");
            asm volatile("s_waitcnt vmcnt(0)" ::: "memory");
            const unsigned og = xb_add(&bar[XB_TOP], 1u);
            const unsigned tg = og / nx;
            if (og + 1u == (tg + 1u) * nx) xb_add(&bar[XB_TOPGEN], 1u);
            else XB_SPIN(xb_ld(&bar[XB_TOPGEN]) == tg, bar);
            __builtin_amdgcn_fence(__ATOMIC_ACQUIRE, "agent");
            xb_add(&bar[XB_XGEN(b.x)], 1u);
            asm volatile("s_waitcnt vmcnt(0)" ::: "memory");
        } else {
            XB_SPIN(xb_ld(&bar[XB_XGEN(b.x)]) == gen, bar);
            __builtin_amdgcn_fence(__ATOMIC_ACQUIRE, "agent");
            asm volatile("s_waitcnt vmcnt(0)" ::: "memory");
        }
    }
    __syncthreads();
}

constexpr size_t ARENA_E = (size_t)(4u << 20) / 2;
struct Team { bool on, same; int pm, j; unsigned* cnt; unsigned* tmo; };
__device__ __forceinline__ bool team_mode() { return gridDim.x == 256; }
__device__ __forceinline__ int my_pm() { const int c = blockIdx.x; return 8 * (c & 7) + ((c >> 3) & 7); }
__device__ __forceinline__ size_t panel_adj(int pm, int ld) { return team_mode() ? (size_t)pm * (ARENA_E - (size_t)256 * ld) : 0; }
__device__ __forceinline__ size_t arena_adj(int ld) { return panel_adj(my_pm(), ld); }
__device__ __forceinline__ size_t h_pstride() { return team_mode() ? ARENA_E : (size_t)(FF / 128) * 32768; }
__device__ __forceinline__ void team_barrier(const Team& T) {
    asm volatile("s_waitcnt vmcnt(0)" ::: "memory");
    __syncthreads();
    if (threadIdx.x == 0) {
        __builtin_amdgcn_s_waitcnt(0);
        if (!T.same) { __builtin_amdgcn_fence(__ATOMIC_RELEASE, "agent"); asm volatile("s_waitcnt vmcnt(0)" ::: "memory"); }
        const unsigned old = xb_add(T.cnt, 1u), target = (old / 4u + 1u) * 4u;
        XB_SPIN(xb_ld(T.cnt) < target, T.tmo);
        __builtin_amdgcn_fence(__ATOMIC_ACQUIRE, "agent");
        asm volatile("s_waitcnt vmcnt(0)" ::: "memory");
    }
    __syncthreads();
}
__device__ __forceinline__ void spatial_phase(LAS unsigned char* lds, const bf16* Z, bf16* GT, const float* vstat, const float* lng, const float* lnb, const float* wsp, const float* bsp) {
    const int tid = threadIdx.x, lane = tid & 63, wid = tid >> 6, fr = lane & 15, fq = lane >> 4, q4 = (lane & 15) >> 2, p4 = lane & 3;
    constexpr int WP = 136, VP = 272;
    LAS bf16* Wl = (LAS bf16*)lds;
    LAS bf16* Vl = (LAS bf16*)(lds + 128 * WP * 2);
    LAS float* MU = (LAS float*)(lds + 128 * WP * 2 + 128 * VP * 2);
    LAS float* RS = MU + 128;
    const int th = wid >> 2, cq = wid & 3;
    const int NUNIT = (M / 128) * 16;
    if ((int)blockIdx.x >= NUNIT) return;
    int g = -1; const int c8 = (tid & 31) * 8; int ch = 0;
    f32x4 g0, g1, b0, b1; float bsv[4];
#define SP_STAGE_G(GG) do { g = (GG); ch = g * 256 + c8; const float* wg_ = wsp + (size_t)g * 128 * 128; \
        _Pragma("unroll") for (int j = 0; j < 8; ++j) { const int e = tid + 512 * j, t = e >> 5, s4 = (e & 31) * 4; f32x4 v = *(const f32x4*)(wg_ + t * 128 + s4); \
            _Pragma("unroll") for (int k = 0; k < 4; ++k) if (s4 + k > t) v[k] = 0.f; \
            u32x2 w; w.x = pk2(v[0], v[1]); w.y = pk2(v[2], v[3]); *(LAS u32x2*)(Wl + t * WP + s4) = w; } \
        g0 = *(const f32x4*)(lng + ch); g1 = *(const f32x4*)(lng + ch + 4); b0 = *(const f32x4*)(lnb + ch); b1 = *(const f32x4*)(lnb + ch + 4); \
        _Pragma("unroll") for (int tt = 0; tt < 4; ++tt) bsv[tt] = bsp[g * 128 + th * 64 + tt * 16 + fr]; } while (0)
    for (int idx = blockIdx.x; idx < NUNIT; idx += gridDim.x) {
        const int chunk = idx >> 4; const size_t rowb = (size_t)chunk * 128;
        const size_t zpan = (size_t)(chunk >> 1) * 2097152; const int zrow = (chunk & 1) * 128;
        if ((idx & 15) != g) SP_STAGE_G(idx & 15);
        u32x4 vw[8]; float s1 = 0.f, s2 = 0.f;
        { const int row = tid >> 2, qq = tid & 3; const f32x4* sp = (const f32x4*)(vstat + ((rowb + row) * 64 + qq * 16) * 2);
          f32x4 sv[8];
#pragma unroll
          for (int j = 0; j < 8; ++j) sv[j] = sp[j];
#pragma unroll
          for (int j = 0; j < 8; ++j) vw[j] = *(const u32x4*)(Z + zpan + (size_t)(16 + g) * 65536 + (size_t)(zrow + (tid >> 5) + 16 * j) * 256 + c8);
#pragma unroll
          for (int j = 0; j < 8; ++j) { s1 += sv[j][0] + sv[j][2]; s2 += sv[j][1] + sv[j][3]; }
          s1 += __shfl_xor(s1, 1); s1 += __shfl_xor(s1, 2); s2 += __shfl_xor(s2, 1); s2 += __shfl_xor(s2, 2);
          const float mean = s1 * (1.0f / GW), var = fmaxf(s2 * (1.0f / GW) - mean * mean, 0.f);
          if (qq == 0) { MU[row] = mean; RS[row] = __builtin_amdgcn_rsqf(var + 1e-5f); } }
        __syncthreads();
#pragma unroll
        for (int j = 0; j < 8; ++j) { const int sr = (tid >> 5) + 16 * j; const u32x4 w = vw[j]; const float mu = MU[sr], rs = RS[sr];
            f32x4 v0 = (f32x4){bflo(w.x), bfhi(w.x), bflo(w.y), bfhi(w.y)}, v1 = (f32x4){bflo(w.z), bfhi(w.z), bflo(w.w), bfhi(w.w)};
            v0 = (v0 - mu) * rs * g0 + b0; v1 = (v1 - mu) * rs * g1 + b1;
            u32x4 o; o.x = pk2(v0[0], v0[1]); o.y = pk2(v0[2], v0[3]); o.z = pk2(v1[0], v1[1]); o.w = pk2(v1[2], v1[3]); *(LAS u32x4*)(Vl + sr * VP + c8) = o; }
        u32x2 uw[4][4];
#pragma unroll
        for (int tt = 0; tt < 4; ++tt)
#pragma unroll
            for (int ct = 0; ct < 4; ++ct) uw[tt][ct] = *(const u32x2*)(Z + zpan + (size_t)g * 65536 + (size_t)(zrow + th * 64 + tt * 16 + fr) * 256 + cq * 64 + ct * 16 + 4 * fq);
        __syncthreads();
        f32x4 acc[4][4];
#pragma unroll
        for (int i = 0; i < 4; ++i)
#pragma unroll
            for (int j = 0; j < 4; ++j) acc[i][j] = (f32x4){0.f, 0.f, 0.f, 0.f};
#pragma unroll
        for (int ks = 0; ks < 4; ++ks) {
            bf16x8 wf[4], vf[4];
#pragma unroll
            for (int tt = 0; tt < 4; ++tt) wf[tt] = *(const LAS bf16x8*)(Wl + (th * 64 + tt * 16 + fr) * WP + ks * 32 + fq * 8);
#pragma unroll
            for (int ct = 0; ct < 4; ++ct) { const LAS bf16* vp = Vl + (ks * 32 + 8 * fq + q4) * VP + cq * 64 + ct * 16 + 4 * p4;
                const s16x4 lo = tr_read(vp), hi = tr_read(vp + 4 * VP); vf[ct] = (bf16x8){lo[0], lo[1], lo[2], lo[3], hi[0], hi[1], hi[2], hi[3]}; }
#pragma unroll
            for (int ct = 0; ct < 4; ++ct)
#pragma unroll
                for (int tt = 0; tt < 4; ++tt) acc[ct][tt] = __builtin_amdgcn_mfma_f32_16x16x32_bf16(vf[ct], wf[tt], acc[ct][tt], 0, 0, 0);
        }
#pragma unroll
        for (int tt = 0; tt < 4; ++tt) { const int t = th * 64 + tt * 16 + fr; const float bv_ = bsv[tt];
#pragma unroll
            for (int ct = 0; ct < 4; ++ct) { const u32x2 w = uw[tt][ct]; bf16* up = GT + zpan + (size_t)g * 65536 + (size_t)(zrow + t) * 256 + cq * 64 + ct * 16 + 4 * fq;
                u32x2 o; o.x = pk2(bflo(w.x) * (acc[ct][tt][0] + bv_), bfhi(w.x) * (acc[ct][tt][1] + bv_)); o.y = pk2(bflo(w.y) * (acc[ct][tt][2] + bv_), bfhi(w.y) * (acc[ct][tt][3] + bv_)); *(u32x2*)up = o; } }
        __syncthreads();
    }
#undef SP_STAGE_G
}

__device__ __forceinline__ void attn_phase(LAS unsigned char* lds, const bf16* QKV, bf16* O, const float* rope, const float* sinks) {
    const size_t adjq = team_mode() ? ARENA_E - (size_t)256 * QKVW : 0, adjo = team_mode() ? ARENA_E - (size_t)256 * D : 0;
    const int tid = threadIdx.x, lane = tid & 63, wid = tid >> 6, fr = lane & 15, fq = lane >> 4, q4 = (lane & 15) >> 2, p4 = lane & 3;
    constexpr int KP = 72;
    LAS bf16* Kl = (LAS bf16*)lds;
    LAS bf16* Vl = (LAS bf16*)(lds + 272 * KP * 2);
    constexpr int NB = SEQ / 128, NU = BATCH * NB * NKV;
    const int r = tid >> 1, half = tid & 1;
    if (tid < 32) {
#pragma unroll
        for (int c = 0; c < 4; ++c) { *(LAS u32x4*)(Kl + (256 + r) * KP + half * 32 + 8 * c) = (u32x4){0u, 0u, 0u, 0u}; *(LAS u32x4*)(Vl + (256 + r) * KP + half * 32 + 8 * c) = (u32x4){0u, 0u, 0u, 0u}; } }
    u32x4 kw[4], vw[4]; f32x4 kr[4];
#define ATT_LOAD_KV(IDX) do { const int kh_ = (IDX) & 3, nb_ = ((IDX) >> 2) % NB, b_ = (IDX) / (4 * NB); const int pos_ = (nb_ - 1) * 128 + r; \
        if (pos_ >= 0) { const size_t krow_ = (size_t)b_ * SEQ + pos_; const bf16* kp_ = QKV + krow_ * QKVW + (krow_ >> 8) * adjq + 2048 + kh_ * 64 + half * 32; \
            _Pragma("unroll") for (int c = 0; c < 4; ++c) { kw[c] = *(const u32x4*)(kp_ + 8 * c); vw[c] = *(const u32x4*)(kp_ + 256 + 8 * c); } \
            const f32x4* rp_ = (const f32x4*)(rope + (size_t)pos_ * 16); _Pragma("unroll") for (int c = 0; c < 4; ++c) kr[c] = rp_[c]; \
        } else { _Pragma("unroll") for (int c = 0; c < 4; ++c) { kw[c] = (u32x4){0u, 0u, 0u, 0u}; vw[c] = (u32x4){0u, 0u, 0u, 0u}; kr[c] = (f32x4){1.f, 0.f, 1.f, 0.f}; } } } while (0)
    int idx = blockIdx.x;
    if (idx < NU) ATT_LOAD_KV(idx);
    while (idx < NU) {
        const int kh = idx & 3, nb = (idx >> 2) % NB, b = idx / (4 * NB);
        { if (half == 0) {
              const float cs[8] = {kr[0][0], kr[0][2], kr[1][0], kr[1][2], kr[2][0], kr[2][2], kr[3][0], kr[3][2]}, sn[8] = {kr[0][1], kr[0][3], kr[1][1], kr[1][3], kr[2][1], kr[2][3], kr[3][1], kr[3][3]};
              float x1[8], x2[8];
#pragma unroll
              for (int e = 0; e < 4; ++e) { x1[2 * e] = bflo(kw[0][e]); x1[2 * e + 1] = bfhi(kw[0][e]); x2[2 * e] = bflo(kw[1][e]); x2[2 * e + 1] = bfhi(kw[1][e]); }
#pragma unroll
              for (int e = 0; e < 4; ++e) { kw[0][e] = pk2(x1[2 * e] * cs[2 * e] - x2[2 * e] * sn[2 * e], x1[2 * e + 1] * cs[2 * e + 1] - x2[2 * e + 1] * sn[2 * e + 1]);
                                            kw[1][e] = pk2(x2[2 * e] * cs[2 * e] + x1[2 * e] * sn[2 * e], x2[2 * e + 1] * cs[2 * e + 1] + x1[2 * e + 1] * sn[2 * e + 1]); } }
#pragma unroll
          for (int c = 0; c < 4; ++c) { *(LAS u32x4*)(Kl + r * KP + half * 32 + 8 * c) = kw[c]; *(LAS u32x4*)(Vl + r * KP + half * 32 + 8 * c) = vw[c]; } }
        __syncthreads();
        const int nidx = idx + gridDim.x;
        if (nidx < NU) ATT_LOAD_KV(nidx);
        const int qh = kh * 8 + wid; const float sink = sinks[qh];
        const size_t qrow0 = (size_t)b * SEQ + nb * 128 + fr;
        u32x4 qw0, qw1; f32x4 qr[4];
#define ATT_LOAD_Q(A) do { const size_t qrw_ = qrow0 + (A) * 16; const bf16* qp_ = QKV + qrw_ * QKVW + (qrw_ >> 8) * adjq + qh * 64 + fq * 8; qw0 = *(const u32x4*)qp_; qw1 = *(const u32x4*)(qp_ + 32); \
        const f32x4* rp_ = (const f32x4*)(rope + (size_t)(nb * 128 + (A) * 16 + fr) * 16); _Pragma("unroll") for (int c = 0; c < 4; ++c) qr[c] = rp_[c]; } while (0)
        ATT_LOAD_Q(0);
        for (int a = 0; a < 8; ++a) {
            const int qi = a * 16 + fr; const size_t qrow = qrow0 + a * 16;
            bf16x8 qf[2];
            { u32x4 w0 = qw0; const u32x4 w1 = qw1;
              const float cs[8] = {qr[0][0], qr[0][2], qr[1][0], qr[1][2], qr[2][0], qr[2][2], qr[3][0], qr[3][2]}, sn[8] = {qr[0][1], qr[0][3], qr[1][1], qr[1][3], qr[2][1], qr[2][3], qr[3][1], qr[3][3]};
              u32x4 pw; pw.x = __shfl_xor(w0.x, 16); pw.y = __shfl_xor(w0.y, 16); pw.z = __shfl_xor(w0.z, 16); pw.w = __shfl_xor(w0.w, 16);
              const float sg = fq == 0 ? -1.f : 1.f;
              u32x4 rw;
#pragma unroll
              for (int e = 0; e < 4; ++e) { const float xa = bflo(w0[e]), xb = bfhi(w0[e]), pa = bflo(pw[e]), pb = bfhi(pw[e]);
                  rw[e] = pk2(xa * cs[2 * e] + sg * pa * sn[2 * e], xb * cs[2 * e + 1] + sg * pb * sn[2 * e + 1]); }
              if (fq < 2) w0 = rw;
              qf[0] = __builtin_bit_cast(bf16x8, w0); qf[1] = __builtin_bit_cast(bf16x8, w1); }
            if (a < 7) ATT_LOAD_Q(a + 1);
            f32x4 sc[10];
#pragma unroll
            for (int j = 0; j < 10; ++j) { const LAS bf16* kp = Kl + ((a + j) * 16 + fr) * KP + fq * 8;
                f32x4 z = (f32x4){0.f, 0.f, 0.f, 0.f};
                z = __builtin_amdgcn_mfma_f32_16x16x32_bf16(*(const LAS bf16x8*)kp, qf[0], z, 0, 0, 0);
                z = __builtin_amdgcn_mfma_f32_16x16x32_bf16(*(const LAS bf16x8*)(kp + 32), qf[1], z, 0, 0, 0);
                sc[j] = z; }
            const int qpos = 128 + qi; float mx = -INFINITY;
#pragma unroll
            for (int j = 0; j < 10; ++j)
#pragma unroll
                for (int e = 0; e < 4; ++e) { const int kpos = (a + j) * 16 + 4 * fq + e; const bool valid = (kpos <= qpos) && (kpos > qpos - 128) && (nb > 0 || kpos >= 128);
                    const float sv = valid ? sc[j][e] * 0.125f : -INFINITY; sc[j][e] = sv; mx = fmaxf(mx, sv); }
            mx = fmaxf(mx, __shfl_xor(mx, 16)); mx = fmaxf(mx, __shfl_xor(mx, 32)); mx = fmaxf(mx, sink);
            float l = 0.f;
#pragma unroll
            for (int j = 0; j < 10; ++j)
#pragma unroll
                for (int e = 0; e < 4; ++e) { const float p = __expf(sc[j][e] - mx); sc[j][e] = p; l += p; }
            l += __shfl_xor(l, 16); l += __shfl_xor(l, 32); l += __expf(sink - mx);
            const float rl = 1.0f / l;
            f32x4 oacc[4];
#pragma unroll
            for (int c = 0; c < 4; ++c) oacc[c] = (f32x4){0.f, 0.f, 0.f, 0.f};
#pragma unroll
            for (int j2 = 0; j2 < 5; ++j2) {
                u32x4 pwv; pwv.x = pk2(sc[2 * j2][0], sc[2 * j2][1]); pwv.y = pk2(sc[2 * j2][2], sc[2 * j2][3]); pwv.z = pk2(sc[2 * j2 + 1][0], sc[2 * j2 + 1][1]); pwv.w = pk2(sc[2 * j2 + 1][2], sc[2 * j2 + 1][3]);
                const bf16x8 pf = __builtin_bit_cast(bf16x8, pwv);
#pragma unroll
                for (int c = 0; c < 4; ++c) { const LAS bf16* vp = Vl + ((a + 2 * j2) * 16 + 4 * fq + q4) * KP + 16 * c + 4 * p4;
                    const s16x4 lo = tr_read(vp), hi = tr_read(vp + 16 * KP);
                    const bf16x8 vf = (bf16x8){lo[0], lo[1], lo[2], lo[3], hi[0], hi[1], hi[2], hi[3]};
                    oacc[c] = __builtin_amdgcn_mfma_f32_16x16x32_bf16(vf, pf, oacc[c], 0, 0, 0); }
            }
            bf16* op = O + qrow * D + (qrow >> 8) * adjo + qh * 64 + 4 * fq;
#pragma unroll
            for (int c = 0; c < 4; ++c) { u32x2 w; w.x = pk2(oacc[c][0] * rl, oacc[c][1] * rl); w.y = pk2(oacc[c][2] * rl, oacc[c][3] * rl); *(u32x2*)(op + 16 * c) = w; }
        }
        __syncthreads();
        idx = nidx;
    }
#undef ATT_LOAD_KV
#undef ATT_LOAD_Q
}

__device__ __forceinline__ void final_phase(float* x, const float* ssq, const float* gn, bool team) {
    const int tid = threadIdx.x, lane = tid & 63, wave = tid >> 6; const int gw = blockIdx.x * 8 + wave, NGW = gridDim.x * 8;
    const int mbeg = team ? my_pm() * 256 + (int)(blockIdx.x >> 6) * 64 + wave : gw, mend = team ? my_pm() * 256 + (int)(blockIdx.x >> 6) * 64 + 64 : M, mstep = team ? 8 : NGW;
    for (int m = mbeg; m < mend; m += mstep) { float s = ssq[(size_t)m * 32 + (lane & 31)];
#pragma unroll
        for (int o = 1; o < 32; o <<= 1) s += __shfl_xor(s, o);
        const float rs = __builtin_amdgcn_rsqf(s * (1.0f / D) + 1e-6f); f32x4* xr = (f32x4*)(x + (size_t)m * D) + lane; const f32x4* gr = (const f32x4*)gn + lane;
#pragma unroll
        for (int j = 0; j < 8; ++j) xr[64 * j] = xr[64 * j] * rs * gr[64 * j]; }
}

__device__ __forceinline__ const LAS float* stage_rstd(LAS unsigned char* lds, const float* ssqp, int N) {
    if (gridDim.x != 256) return nullptr;
    pg8::StaticOrder S; S.init(M, N, 256, blockIdx.x); pg8::Unit u; if (!S.next(0, u)) return nullptr;
    LAS float* RS = (LAS float*)(lds + 131072 + 2048);
    const int t = threadIdx.x;
    if (t < 256) { const f32x4* p = (const f32x4*)(ssqp + (size_t)(u.pm * 256 + t) * 32); float sm = 0.f;
#pragma unroll
        for (int j = 0; j < 8; ++j) { const f32x4 v = p[j]; sm += (v[0] + v[1]) + (v[2] + v[3]); }
        RS[t] = __builtin_amdgcn_rsqf(sm * (1.0f / D) + 1e-6f); }
    __syncthreads();
    return RS;
}
#define IN(k) (lo <= (k) && (k) < hi)
#define SEAM(k) do { if (IN(k) && IN((k) + 1)) xcd_barrier(bar); } while (0)
#define SEAM_T(k) do { if (IN(k) && IN((k) + 1)) { if (T.on) team_barrier(T); else xcd_barrier(bar); } } while (0)
template <int F, int L> __device__ __forceinline__ void ph_ffn_up(const Args& a, LAS unsigned char* lds) {
    unsigned char* ws = a.ws;
    pg8::Gemm g{(const bf16*)(ws + WS_XB0), (const bf16*)(ws + WS_W13 + (size_t)(F * 2 + L) * SZ_W13), M, 2 * FF, D, 256, (size_t)256 * D * 2, 131072, 2}; pg8::StaticOrder S; S.init(M, 2 * FF, gridDim.x, blockIdx.x);
    pg8::EpiSwiGLU E{(bf16*)(ws + WS_BIG), h_pstride(), (const float*)(ws + WS_SS0), stage_rstd(lds, (const float*)(ws + WS_SS0), 2 * FF)};
    pg8::gemm_phase<pg8::EpiSwiGLU, pg8::StaticOrder, true, true>(lds, g, S, E);
}
template <int L> __device__ __forceinline__ void ph_ple_proj(const Args& a, LAS unsigned char* lds, int nvirt = 1) {
    unsigned char* ws = a.ws;
    pg8::Gemm g{(const bf16*)(ws + WS_PB) + (size_t)L * M * PLE, (const bf16*)(ws + WS_WP + (size_t)L * SZ_WP), M, D, PLE, PLE};
    pg8::EpiQKV E{(bf16*)(ws + WS_PJ), D, nullptr, nullptr, nullptr, nullptr, nullptr};
    for (int v = 0; v < nvirt; ++v) { pg8::StaticOrder S; S.init(M, D, gridDim.x, (int)blockIdx.x - 128 * v);
        pg8::gemm_phase<pg8::EpiQKV, pg8::StaticOrder, true, true>(lds, g, S, E); }
}
template <int F, int L> __device__ __forceinline__ void ph_ffn_down(const Args& a, LAS unsigned char* lds) {
    unsigned char* ws = a.ws;
    pg8::Gemm g{(const bf16*)(ws + WS_BIG), (const bf16*)(ws + WS_W2 + (size_t)(F * 2 + L) * SZ_W2), M, D, FF, 128, h_pstride() * 2, 65536, 1}; pg8::StaticOrder S; S.init(M, D, gridDim.x, blockIdx.x);
    constexpr bool FIRST = (F == 0 && L == 0);
    pg8::EpiResid<FIRST> E{a.in[0], (const bf16*)(ws + WS_XB0), (bf16*)(ws + WS_XB1), (float*)(ws + WS_SS1), nullptr, 0.5f};
    pg8::gemm_phase<pg8::EpiResid<FIRST>, pg8::StaticOrder, true, true>(lds, g, S, E);
}
template <int L> __device__ __forceinline__ void ph_mix_out(const Args& a, LAS unsigned char* lds) {
    unsigned char* ws = a.ws;
    pg8::Gemm g = (L == 0) ? pg8::Gemm{(const bf16*)(ws + WS_BIG), (const bf16*)(ws + WS_WOUT), M, D, GW, 256, (size_t)4 << 20, 131072, 2}
                           : pg8::Gemm{(const bf16*)(ws + WS_BIG) + (team_mode() ? (size_t)256 * QKVW + arena_adj(D) : (size_t)M * QKVW), (const bf16*)(ws + WS_WO), M, D, D, D};
    pg8::StaticOrder S; S.init(M, D, gridDim.x, blockIdx.x);
    pg8::EpiResid<false> E{nullptr, (const bf16*)(ws + WS_XB1), (bf16*)(ws + WS_XB0), (float*)(ws + WS_SS0), L == 0 ? nullptr : a.in[28], 1.0f};
    pg8::gemm_phase<pg8::EpiResid<false>, pg8::StaticOrder, true, true>(lds, g, S, E);
}
template <int L> __device__ __forceinline__ void ph_mix_in(const Args& a, LAS unsigned char* lds, bool pp_here) {
    unsigned char* ws = a.ws;
    if constexpr (L == 0) {
        pg8::Gemm g{(const bf16*)(ws + WS_XB1), (const bf16*)(ws + WS_WIN), M, 2 * GW, D, 256, (size_t)256 * D * 2, 131072, 2}; pg8::StaticOrder S; S.init(M, 2 * GW, gridDim.x, blockIdx.x);
        pg8::EpiGelu E{(bf16*)(ws + WS_BIG), 2 * GW, (const float*)(ws + WS_SS1), (float*)(ws + WS_VSTAT), stage_rstd(lds, (const float*)(ws + WS_SS1), 2 * GW)};
        pg8::gemm_phase<pg8::EpiGelu, pg8::StaticOrder, true, true>(lds, g, S, E);
    } else {
        pg8::Gemm g{(const bf16*)(ws + WS_XB1), (const bf16*)(ws + WS_WQKV), M, QKVW, D, 256, (size_t)256 * D * 2, 131072, 2}; pg8::StaticOrder S; S.init(M, QKVW, gridDim.x, blockIdx.x);
        pg8::EpiQKV E{(bf16*)(ws + WS_BIG) + arena_adj(QKVW), QKVW, (const float*)(ws + WS_SS1), a.in[21], a.in[23], a.in[25], stage_rstd(lds, (const float*)(ws + WS_SS1), QKVW)};
        pg8::gemm_phase<pg8::EpiQKV, pg8::StaticOrder, true, true>(lds, g, S, E);
        if (pp_here && blockIdx.x >= 128) ph_ple_proj<L>(a, lds, 2);
    }
}
template <int L> __device__ __forceinline__ void ph_ple_gate(const Args& a, LAS unsigned char* lds) {
    unsigned char* ws = a.ws;
    pg8::Gemm g{(const bf16*)(ws + WS_XB1), (const bf16*)(ws + WS_WG + (size_t)L * SZ_WG), M, D, D, 256, (size_t)256 * D * 2, 131072, 2}; pg8::StaticOrder S; S.init(M, D, gridDim.x, blockIdx.x);
    pg8::EpiPLE<(L == 1)> E{(const bf16*)(ws + WS_XB1), a.out, (bf16*)(ws + WS_XB0), (float*)(ws + WS_SS0), (const float*)(ws + WS_SS1), (const bf16*)(ws + WS_PJ), stage_rstd(lds, (const float*)(ws + WS_SS1), D)};
    pg8::gemm_phase<pg8::EpiPLE<(L == 1)>, pg8::StaticOrder, true, true>(lds, g, S, E);
}
template <int L> __device__ __forceinline__ void layer(const Args& a, LAS unsigned char* lds, const int lo, const int hi, const XcdBarrier& bar, const Team& T) {
    constexpr int P = 1 + 8 * L; unsigned char* ws = a.ws;
    if (IN(P + 0)) ph_ffn_up<0, L>(a, lds);
    SEAM_T(P + 0);
    if (IN(P + 1)) ph_ffn_down<0, L>(a, lds);
    SEAM_T(P + 1);
    const bool pp_in_qkv = (L == 1) && T.on;
    if (IN(P + 2)) ph_mix_in<L>(a, lds, pp_in_qkv);
    SEAM(P + 2);
    if (IN(P + 3)) {
        if constexpr (L == 0) spatial_phase(lds, (const bf16*)(ws + WS_BIG), (bf16*)(ws + WS_BIG), (const float*)(ws + WS_VSTAT), a.in[15], a.in[16], a.in[17], a.in[18]);
        else attn_phase(lds, (const bf16*)(ws + WS_BIG), (bf16*)(ws + WS_BIG) + (team_mode() ? (size_t)256 * QKVW : (size_t)M * QKVW), (const float*)(ws + WS_ROPE), a.in[26]);
    }
    SEAM(P + 3);
    if (IN(P + 4)) ph_mix_out<L>(a, lds);
    SEAM_T(P + 4);
    if (IN(P + 5)) { ph_ffn_up<1, L>(a, lds); if (!pp_in_qkv) ph_ple_proj<L>(a, lds); }
    SEAM_T(P + 5);
    if (IN(P + 6)) ph_ffn_down<1, L>(a, lds);
    SEAM_T(P + 6);
    if (IN(P + 7)) ph_ple_gate<L>(a, lds);
    SEAM_T(P + 7);
}
__global__ void __launch_bounds__(512, 2) mega_fwd(Args a) {
    extern __shared__ __attribute__((aligned(16))) unsigned char lds_raw[];
    LAS unsigned char* lds = (LAS unsigned char*)lds_raw;
    const int lo = a.lo, hi = a.hi;
    unsigned* barw = (unsigned*)(a.ws + WS_CTL);
    volatile LAS unsigned* MISC = (volatile LAS unsigned*)(lds + MISC_OFF);
    if (threadIdx.x < 16) MISC[threadIdx.x] = 0u;
    if (IN(0)) {
        if (blockIdx.x == 0) for (int i = threadIdx.x; i < 8192; i += 512) __hip_atomic_store(barw + i, 0u, __ATOMIC_RELAXED, __HIP_MEMORY_SCOPE_AGENT);
        if (threadIdx.x == 0) __hip_atomic_store(barw + 8192 + blockIdx.x, xb_xcc_id() + 1u, __ATOMIC_RELAXED, __HIP_MEMORY_SCOPE_AGENT);
        p0_prologue(a, lds);
    }
    __syncthreads();
    XcdBarrier bar; bar.bar = barw; bar.x = 0; bar.st = nullptr;
    Team T; T.on = false; T.same = false; T.pm = my_pm(); T.j = blockIdx.x >> 6; T.cnt = barw + 4096 + 64 * T.pm; T.tmo = barw;
    if (IN(0) && IN(1)) { cg::this_grid().sync(); bar = xcd_barrier_post(barw, MISC + 8);
        if (team_mode() && lo == 0 && hi == NPHASE) {
            if (threadIdx.x == 0) { const unsigned me = xb_xcc_id() + 1u; bool sm = true;
#pragma unroll
                for (int j = 0; j < 4; ++j) sm = sm && (xb_ld(barw + 8192 + (blockIdx.x & 63) + 64 * j) == me);
                MISC[12] = sm ? 1u : 0u; }
            __syncthreads();
            T.on = true; T.same = MISC[12] != 0u; } }
    layer<0>(a, lds, lo, hi, bar, T);
    layer<1>(a, lds, lo, hi, bar, T);
    if (IN(NPHASE - 1)) final_phase(a.out, (const float*)(a.ws + WS_SS0), a.in[29], T.on);
}
#undef IN
#undef SEAM
#undef SEAM_T

extern "C" void kernel_launch(void* const* d_in, const int* in_sizes, int n_in, void* d_out, int out_size, void* d_ws, size_t ws_size, hipStream_t stream) {
    static int grid = 0;
    if (grid == 0) {
        if (n_in != 30 || in_sizes[0] != M * D || out_size != M * D || ws_size < WS_END) { fprintf(stderr, "kernel_launch: unexpected shapes / workspace (n_in %d, in0 %d, out %d, ws %zu, need %zu)\n", n_in, n_in > 0 ? in_sizes[0] : -1, out_size, ws_size, (size_t)WS_END); grid = -1; return; }
        int dev = 0, cus = 0, per_cu = 0;
        if (hipGetDevice(&dev) != hipSuccess || hipDeviceGetAttribute(&cus, hipDeviceAttributeMultiprocessorCount, dev) != hipSuccess) { grid = -1; return; }
        if (hipFuncSetAttribute((const void*)mega_fwd, hipFuncAttributeMaxDynamicSharedMemorySize, LDS_BYTES) != hipSuccess) { fprintf(stderr, "kernel_launch: hipFuncSetAttribute failed\n"); grid = -1; return; }
        if (hipOccupancyMaxActiveBlocksPerMultiprocessor(&per_cu, (const void*)mega_fwd, 512, LDS_BYTES) != hipSuccess || per_cu < 1) { fprintf(stderr, "kernel_launch: occupancy query says %d blocks per CU\n", per_cu); per_cu = 1; }
        (void)hipGetLastError();
        grid = cus * (per_cu > 1 ? 1 : per_cu);
    }
    if (grid < 0) return;
    Args a{};
    for (int i = 0; i < 30; ++i) a.in[i] = (const float*)d_in[i];
    a.out = (float*)d_out; a.ws = (unsigned char*)d_ws;
    for (int j = 0; j < 8; ++j) a.invf[j] = (float)pow(500000.0, -(double)(2 * j) / 16.0);
#if MK_MULTI
    for (int ph = 0; ph < NPHASE; ++ph) { a.lo = ph; a.hi = ph + 1; hipLaunchKernelGGL(mega_fwd, dim3(grid), dim3(512), LDS_BYTES, stream, a); }
#else
    a.lo = 0; a.hi = NPHASE;
    void* args[] = {&a};
    hipError_t e = hipLaunchCooperativeKernel((const void*)mega_fwd, dim3(grid), dim3(512), args, LDS_BYTES, stream);
    if (e != hipSuccess) fprintf(stderr, "kernel_launch: cooperative launch failed: %s (grid %d)\n", hipGetErrorString(e), grid);
#endif
}
```

```cpp
#include <hip/hip_runtime.h>
#include <cstdio>
#include <cstdint>
#include <cmath>
namespace pg8 {
#define PG8_LAS __attribute__((address_space(3)))
typedef unsigned short bf16_t;
typedef short bf16x8 __attribute__((ext_vector_type(8)));
typedef float f32x4 __attribute__((ext_vector_type(4)));
typedef unsigned u32x4 __attribute__((ext_vector_type(4)));
constexpr int BM = 256, BK = 64, HALF = 128, HTB = HALF * BK * 2  , STAGE_BYTES = 8 * HTB, NXCD = 8, WGM = 8;

__host__ __device__ __forceinline__ int lds_byte(int r, int c) { const int st = (r >> 4) * 2 + (c >> 5), rr = r & 15, cc = c & 31, ob = rr * 64 + cc * 2; return st * 1024 + (ob ^ (((ob >> 9) & 1) << 5)); }
__host__ __device__ __forceinline__ void stage_rc(int b, int& R, int& C) { const int st = b / 1024, sb = b % 1024, swz = sb ^ (((sb >> 9) & 1) << 5); R = (st >> 1) * 16 + swz / 64; C = (st & 1) * 32 + (swz % 64) / 2; }
__host__ __device__ __forceinline__ int perm32(int rho) { const int n = rho >> 4, i = rho & 15; return 8 * (i >> 2) + 4 * n + (i & 3); }

struct Unit { int pm, pn; };
struct Gemm { const bf16_t* A; const bf16_t* Bt; int M, N, K, lda; size_t a_tstep; int a_blk, a_sh; };

struct StaticOrder {
    int nM, nN, nwg, G, c;
    __host__ __device__ void init(int M, int N, int G_, int c_) { nM = M / BM; nN = N / BM; nwg = nM * nN; G = G_; c = c_; }
    __host__ __device__ bool next(int i, Unit& u) const {
        const long L = (long)i * G + c; if (L >= nwg) return false;
        int wgid = (int)L; { const int q = nwg / NXCD, r = nwg % NXCD, xcd = wgid % NXCD, off = wgid / NXCD; wgid = (xcd < r ? xcd * (q + 1) : r * (q + 1) + (xcd - r) * q) + off; }
        const int nig = WGM * nN, gid = wgid / nig, fm = gid * WGM, gsz = (nM - fm) < WGM ? (nM - fm) : WGM;
        u.pm = fm + ((wgid % nig) % gsz); u.pn = (wgid % nig) / gsz; return true;
    }
    __device__ __forceinline__ void a_ready(const Unit&) const {}
    __device__ __forceinline__ void done(const Unit&) const {}
};

__device__ __forceinline__ unsigned cvt_pk_bf16(float lo, float hi) { unsigned r; asm volatile("v_cvt_pk_bf16_f32 %0, %1, %2" : "=v"(r) : "v"(lo), "v"(hi)); return r; }
typedef float f32x2 __attribute__((ext_vector_type(2)));
__device__ __forceinline__ f32x2 gelu_pk(f32x2 v) {
    const f32x2 av = __builtin_elementwise_abs(v), d = av * 0.2316418882f + 1.0f;
    f32x2 t; t.x = __builtin_amdgcn_rcpf(d.x); t.y = __builtin_amdgcn_rcpf(d.y);
    f32x2 q = t * 0.5307027145f + (-0.7265760135f); q = q * t + 0.7107068705f; q = q * t + (-0.142248368f); q = q * t + 0.127414796f; q = q * t;
    const f32x2 s = (v * v) * (-0.72134752044f);
    f32x2 e; e.x = __builtin_amdgcn_exp2f(s.x); e.y = __builtin_amdgcn_exp2f(s.y);
    const f32x2 m = v * (q * e), r = v - m;
    f32x2 o; o.x = v.x < 0.f ? m.x : r.x; o.y = v.y < 0.f ? m.y : r.y; return o;
}
constexpr int XD = 2048;
typedef unsigned u32x2 __attribute__((ext_vector_type(2)));
__device__ __forceinline__ float row_rstd(const float* ssqp, int row, int fq) {
    const f32x4* p = (const f32x4*)(ssqp + (size_t)row * 32 + fq * 8);
    const f32x4 a = p[0], b = p[1];
    float s = ((a[0] + a[1]) + (a[2] + a[3])) + ((b[0] + b[1]) + (b[2] + b[3]));
    s += __shfl_xor(s, 16); s += __shfl_xor(s, 32);
    return __builtin_amdgcn_rsqf(s * (1.0f / 2048.0f) + 1e-6f);
}
__device__ __forceinline__ float tile_rstd(const PG8_LAS float* rsl, const float* ssqp, int row, int fq) { return rsl ? rsl[row & (BM - 1)] : row_rstd(ssqp, row, fq); }
__device__ __forceinline__ float sigmoid_f(float z) { return __builtin_amdgcn_rcpf(1.0f + __builtin_amdgcn_exp2f(z * -1.4426950408889634f)); }
__device__ __forceinline__ u32x4 pack8(const f32x4& v0, const f32x4& v1) { u32x4 w; w.x = cvt_pk_bf16(v0[0], v0[1]); w.y = cvt_pk_bf16(v0[2], v0[3]); w.z = cvt_pk_bf16(v1[0], v1[1]); w.w = cvt_pk_bf16(v1[2], v1[3]); return w; }
__device__ __forceinline__ float bf_lo(unsigned w) { return __uint_as_float(w << 16); }
__device__ __forceinline__ float bf_hi(unsigned w) { return __uint_as_float(w & 0xffff0000u); }

struct EpiSwiGLU {
    static constexpr bool PERM = true, AFTER_DRAIN = false;
    bf16_t* H; size_t pstride; const float* ssqp; const PG8_LAS float* rsl;
    __device__ __forceinline__ void operator()(const f32x4 (&acc)[2][2][4][2], const Unit& u, int wr, int wc, int fr, int fq) const {
        const int row0 = u.pm * BM + wr * 64 + fr, col0 = u.pn * HALF + wc * 32 + 8 * fq;
        float rs[2][4];
#pragma unroll
        for (int ai = 0; ai < 2; ++ai) {
#pragma unroll
            for (int m = 0; m < 4; ++m) rs[ai][m] = tile_rstd(rsl, ssqp, row0 + ai * HALF + m * 16, fq);
            asm volatile("" ::: "memory"); }
        asm volatile("" ::: "memory");
#pragma unroll
        for (int ai = 0; ai < 2; ++ai)
#pragma unroll
            for (int m = 0; m < 4; ++m) { const int row = row0 + ai * HALF + m * 16; const float r = rs[ai][m];
                f32x4 h[2];
#pragma unroll
                for (int n = 0; n < 2; ++n) { const f32x4 a = acc[ai][0][m][n] * r, b = acc[ai][1][m][n] * r;
#pragma unroll
                    for (int e = 0; e < 4; ++e) h[n][e] = a[e] * b[e] * sigmoid_f(a[e]); }
                *(u32x4*)(H + (size_t)u.pm * pstride + (size_t)u.pn * 32768 + (size_t)(wr * 64 + fr + ai * HALF + m * 16) * HALF + wc * 32 + 8 * fq) = pack8(h[0], h[1]); }
    }
};
__device__ __forceinline__ void unpack8(const u32x4& w, f32x4& v0, f32x4& v1) { v0 = (f32x4){bf_lo(w.x), bf_hi(w.x), bf_lo(w.y), bf_hi(w.y)}; v1 = (f32x4){bf_lo(w.z), bf_hi(w.z), bf_lo(w.w), bf_hi(w.w)}; }
template <bool F32IN> struct EpiResid {
    static constexpr bool PERM = true, AFTER_DRAIN = false;
    static constexpr int NB = F32IN ? 2 : 8;
    const float* xin_f; const bf16_t* xin_b; bf16_t* xb; float* ssq_out; const float* bias; float alpha;
    __device__ __forceinline__ void operator()(const f32x4 (&acc)[2][2][4][2], const Unit& u, int wr, int wc, int fr, int fq) const {
        const int row0 = u.pm * BM + wr * 64 + fr, col0 = u.pn * BM + wc * 32 + 8 * fq;
        const size_t tb = (size_t)(u.pm * 8 + u.pn) * 65536 + wc * 32 + 8 * fq; const int rit0 = wr * 64 + fr;
        f32x4 bv[2][2];
#pragma unroll
        for (int bj = 0; bj < 2; ++bj)
#pragma unroll
            for (int n = 0; n < 2; ++n) bv[bj][n] = bias ? *(const f32x4*)(bias + col0 + bj * HALF + 4 * n) : (f32x4){0.f, 0.f, 0.f, 0.f};
#pragma unroll
        for (int bt = 0; bt < 8 / NB; ++bt) {
            f32x4 xv[F32IN ? NB : 1][2][2]; u32x4 xw[F32IN ? 1 : NB][2];
#pragma unroll
            for (int mm = 0; mm < NB; ++mm)
#pragma unroll
                for (int bj = 0; bj < 2; ++bj) { const int rg = NB * bt + mm;
                    if constexpr (F32IN) { const size_t off = (size_t)(row0 + (rg >> 2) * HALF + (rg & 3) * 16) * XD + col0 + bj * HALF; xv[mm][bj][0] = *(const f32x4*)(xin_f + off); xv[mm][bj][1] = *(const f32x4*)(xin_f + off + 4); }
                    else xw[mm][bj] = *(const u32x4*)(xin_b + tb + (size_t)(rit0 + (rg >> 2) * HALF + (rg & 3) * 16) * BM + bj * HALF); }
            asm volatile("" ::: "memory");
#pragma unroll
            for (int mm = 0; mm < NB; ++mm) { const int rg = NB * bt + mm, ai = rg >> 2, m = rg & 3; const int row = row0 + ai * HALF + m * 16; float ss = 0.f;
#pragma unroll
                for (int bj = 0; bj < 2; ++bj) {
                    f32x4 x0, x1; if constexpr (F32IN) { x0 = xv[mm][bj][0]; x1 = xv[mm][bj][1]; } else unpack8(xw[mm][bj], x0, x1);
                    const f32x4 v0 = x0 + acc[ai][bj][m][0] * alpha + bv[bj][0], v1 = x1 + acc[ai][bj][m][1] * alpha + bv[bj][1];
                    *(u32x4*)(xb + tb + (size_t)(rit0 + ai * HALF + m * 16) * BM + bj * HALF) = pack8(v0, v1);
                    ss += (v0[0] * v0[0] + v0[1] * v0[1]) + (v0[2] * v0[2] + v0[3] * v0[3]) + (v1[0] * v1[0] + v1[1] * v1[1]) + (v1[2] * v1[2] + v1[3] * v1[3]); }
                ss += __shfl_xor(ss, 16); ss += __shfl_xor(ss, 32);
                if (fq == 0) ssq_out[(size_t)row * 32 + u.pn * 4 + wc] = ss; }
            asm volatile("" ::: "memory");
        }
    }
};
struct EpiGelu {
    static constexpr bool PERM = true, AFTER_DRAIN = false;
    bf16_t* Z; int ldz; const float* ssqp; float* vstat; const PG8_LAS float* rsl;
    __device__ __forceinline__ void operator()(const f32x4 (&acc)[2][2][4][2], const Unit& u, int wr, int wc, int fr, int fq) const {
        const int row0 = u.pm * BM + wr * 64 + fr, col0 = u.pn * BM + wc * 32 + 8 * fq;
        float rsv[2][4];
#pragma unroll
        for (int ai = 0; ai < 2; ++ai) {
#pragma unroll
            for (int m = 0; m < 4; ++m) rsv[ai][m] = tile_rstd(rsl, ssqp, row0 + ai * HALF + m * 16, fq);
            asm volatile("" ::: "memory"); }
        asm volatile("" ::: "memory");
#pragma unroll
        for (int ai = 0; ai < 2; ++ai)
#pragma unroll
            for (int m = 0; m < 4; ++m) { const int row = row0 + ai * HALF + m * 16; const float rs = rsv[ai][m]; float s1 = 0.f, s2 = 0.f;
#pragma unroll
                for (int bj = 0; bj < 2; ++bj) { f32x4 v0 = acc[ai][bj][m][0] * rs, v1 = acc[ai][bj][m][1] * rs;
                    const f32x2 a = gelu_pk((f32x2){v0[0], v0[1]}), b = gelu_pk((f32x2){v0[2], v0[3]}), c = gelu_pk((f32x2){v1[0], v1[1]}), d = gelu_pk((f32x2){v1[2], v1[3]});
                    v0 = (f32x4){a.x, a.y, b.x, b.y}; v1 = (f32x4){c.x, c.y, d.x, d.y};
                    *(u32x4*)(Z + (size_t)u.pm * 2097152 + (size_t)u.pn * 65536 + (size_t)(wr * 64 + fr + ai * HALF + m * 16) * BM + wc * 32 + 8 * fq + bj * HALF) = pack8(v0, v1);
                    s1 += ((v0[0] + v0[1]) + (v0[2] + v0[3])) + ((v1[0] + v1[1]) + (v1[2] + v1[3]));
                    s2 += (v0[0] * v0[0] + v0[1] * v0[1]) + (v0[2] * v0[2] + v0[3] * v0[3]) + (v1[0] * v1[0] + v1[1] * v1[1]) + (v1[2] * v1[2] + v1[3] * v1[3]); }
                if (u.pn >= 16) { s1 += __shfl_xor(s1, 16); s1 += __shfl_xor(s1, 32); s2 += __shfl_xor(s2, 16); s2 += __shfl_xor(s2, 32);
                    if (fq == 0) *(f32x2*)(vstat + ((size_t)row * 64 + (u.pn - 16) * 4 + wc) * 2) = (f32x2){s1, s2}; } }
    }
};
struct EpiQKV {
    static constexpr bool PERM = true, AFTER_DRAIN = false;
    bf16_t* O; int ldo; const float* ssqp; const float* bq; const float* bk; const float* bv; const PG8_LAS float* rsl;
    __device__ __forceinline__ void operator()(const f32x4 (&acc)[2][2][4][2], const Unit& u, int wr, int wc, int fr, int fq) const {
        const int row0 = u.pm * BM + wr * 64 + fr, cin = wc * 32 + 8 * fq, col0 = u.pn * BM + cin;
        const float* bp = bq ? (u.pn < 8 ? bq + u.pn * BM : (u.pn == 8 ? bk : bv)) + cin : nullptr;
        f32x4 bvv[2][2];
#pragma unroll
        for (int bj = 0; bj < 2; ++bj)
#pragma unroll
            for (int n = 0; n < 2; ++n) bvv[bj][n] = bp ? *(const f32x4*)(bp + bj * HALF + 4 * n) : (f32x4){0.f, 0.f, 0.f, 0.f};
#pragma unroll
        for (int ai = 0; ai < 2; ++ai) {
            float rsv[4];
#pragma unroll
            for (int m = 0; m < 4; ++m) rsv[m] = ssqp ? tile_rstd(rsl, ssqp, row0 + ai * HALF + m * 16, fq) : 1.0f;
            asm volatile("" ::: "memory");
#pragma unroll
            for (int m = 0; m < 4; ++m) { const int row = row0 + ai * HALF + m * 16; const float rs = rsv[m];
#pragma unroll
                for (int bj = 0; bj < 2; ++bj) *(u32x4*)(O + (size_t)row * ldo + col0 + bj * HALF) = pack8(acc[ai][bj][m][0] * rs + bvv[bj][0], acc[ai][bj][m][1] * rs + bvv[bj][1]); }
            asm volatile("" ::: "memory");
        }
    }
};
template <bool LAST> struct EpiPLE {
    static constexpr bool PERM = true, AFTER_DRAIN = false;
    const bf16_t* xin_b; float* xout_f; bf16_t* xb; float* ssq_out; const float* ssqp; const bf16_t* pj; const PG8_LAS float* rsl;
    __device__ __forceinline__ void operator()(const f32x4 (&acc)[2][2][4][2], const Unit& u, int wr, int wc, int fr, int fq) const {
        const int row0 = u.pm * BM + wr * 64 + fr, col0 = u.pn * BM + wc * 32 + 8 * fq;
        const size_t tb = (size_t)(u.pm * 8 + u.pn) * 65536 + wc * 32 + 8 * fq; const int rit0 = wr * 64 + fr;
#pragma unroll
        for (int ai = 0; ai < 2; ++ai)
#pragma unroll
            for (int mh = 0; mh < 2; ++mh) {
                float rsv[2];
#pragma unroll
                for (int mm = 0; mm < 2; ++mm) rsv[mm] = tile_rstd(rsl, ssqp, row0 + ai * HALF + (2 * mh + mm) * 16, fq);
                u32x4 xw[2][2], pv[2][2];
#pragma unroll
                for (int mm = 0; mm < 2; ++mm)
#pragma unroll
                    for (int bj = 0; bj < 2; ++bj) { const size_t off = (size_t)(row0 + ai * HALF + (2 * mh + mm) * 16) * XD + col0 + bj * HALF; xw[mm][bj] = *(const u32x4*)(xin_b + tb + (size_t)(rit0 + ai * HALF + (2 * mh + mm) * 16) * BM + bj * HALF); pv[mm][bj] = *(const u32x4*)(pj + off); }
                asm volatile("" ::: "memory");
#pragma unroll
                for (int mm = 0; mm < 2; ++mm) { const int m = 2 * mh + mm; const int row = row0 + ai * HALF + m * 16; const size_t off = (size_t)row * XD + col0; const float rs = rsv[mm]; float ss = 0.f;
#pragma unroll
                    for (int bj = 0; bj < 2; ++bj) { f32x4 x0, x1, p0, p1; unpack8(xw[mm][bj], x0, x1); unpack8(pv[mm][bj], p0, p1);
                        f32x4 v0, v1;
#pragma unroll
                        for (int e = 0; e < 4; ++e) { v0[e] = x0[e] + sigmoid_f(acc[ai][bj][m][0][e] * rs) * p0[e]; v1[e] = x1[e] + sigmoid_f(acc[ai][bj][m][1][e] * rs) * p1[e]; }
                        if constexpr (LAST) { *(f32x4*)(xout_f + off + bj * HALF) = v0; *(f32x4*)(xout_f + off + bj * HALF + 4) = v1; }
                        else *(u32x4*)(xb + tb + (size_t)(rit0 + ai * HALF + m * 16) * BM + bj * HALF) = pack8(v0, v1);
                        ss += (v0[0] * v0[0] + v0[1] * v0[1]) + (v0[2] * v0[2] + v0[3] * v0[3]) + (v1[0] * v1[0] + v1[1] * v1[1]) + (v1[2] * v1[2] + v1[3] * v1[3]); }
                    ss += __shfl_xor(ss, 16); ss += __shfl_xor(ss, 32);
                    if (fq == 0) ssq_out[(size_t)row * 32 + u.pn * 4 + wc] = ss; }
                asm volatile("" ::: "memory");
            }
    }
};

template <class Epi, class Sched, bool ALIGN_EPI = false, bool SP2 = false>
__device__ __forceinline__ void gemm_phase(PG8_LAS unsigned char* lds, const Gemm g, const Sched& S, const Epi& E) {
    const int tid = threadIdx.x, wid = __builtin_amdgcn_readfirstlane(tid >> 6), lane = tid & 63, wr = wid >> 2, wc = wid & 3, fr = lane & 15, fq = lane >> 4;
    const int K = g.K, nt = K / BK;
    unsigned voffA[2], voffB[2];
#pragma unroll
    for (int i = 0; i < 2; ++i) { int R, C; stage_rc(tid * 16 + i * 8192, R, C); const int Rb = Epi::PERM ? ((R & ~31) + perm32(R & 31)) : R;
        voffA[i] = (unsigned)(R * g.lda + C) * 2u; voffB[i] = (unsigned)(Rb * K + C) * 2u; }
    const size_t kstep = (size_t)(BK * 2);
    const size_t hstepA = (size_t)HALF * g.lda * 2, hstepB = (size_t)HALF * K * 2;
    const size_t tstepA = g.a_tstep ? g.a_tstep : 2 * hstepA, tstepB = 2 * hstepB;
    const unsigned ldsw = (unsigned)wid * 1024u;
    const int aoff = lds_byte(wr * 64 + fr, fq * 8), boff = lds_byte(wc * 32 + fr, fq * 8);
#define PG8_SA(b, h) (((b) * 2 + (h)) * HTB)
#define PG8_SB(b, h) ((4 + (b) * 2 + (h)) * HTB)
#define PG8_STAGE(bufoff, gbase, voff) do { const unsigned long long gb_ = (unsigned long long)(gbase); _Pragma("unroll") for (int _i = 0; _i < 2; ++_i) { unsigned keep_; \
        asm volatile("s_mov_b32 m0, %2\n\ts_nop 0\n\tglobal_load_lds_dwordx4 %0, %1" : : "v"((voff)[_i]), "s"(gb_), "s"((unsigned)(size_t)(lds + (bufoff) + ldsw + _i * 8192)) : "memory", "m0"); (void)keep_; } } while (0)
#define PG8_LDA(dst, b, h) do { _Pragma("unroll") for (int m = 0; m < 4; ++m) _Pragma("unroll") for (int k = 0; k < 2; ++k) dst[m][k] = *(const PG8_LAS bf16x8*)(lds + PG8_SA(b, h) + aoff + m * 2048 + k * 1024); } while (0)
#define PG8_LDB(dst, b, h) do { _Pragma("unroll") for (int n = 0; n < 2; ++n) _Pragma("unroll") for (int k = 0; k < 2; ++k) dst[n][k] = *(const PG8_LAS bf16x8*)(lds + PG8_SB(b, h) + boff + n * 2048 + k * 1024); } while (0)
#define PG8_MMA(ai, bj, At, Bt) do { __builtin_amdgcn_s_setprio(1); _Pragma("unroll") for (int m = 0; m < 4; ++m) _Pragma("unroll") for (int n = 0; n < 2; ++n) _Pragma("unroll") for (int k = 0; k < 2; ++k) \
        acc[ai][bj][m][n] = __builtin_amdgcn_mfma_f32_16x16x32_bf16(Bt[n][k], At[m][k], acc[ai][bj][m][n], 0, 0, 0); __builtin_amdgcn_s_setprio(0); } while (0)
#define PG8_WAIT_V(n) asm volatile("s_waitcnt vmcnt(" #n ")" ::: "memory")
#define PG8_WAIT_L(n) asm volatile("s_waitcnt lgkmcnt(" #n ")" ::: "memory")
#define PG8_BAR __builtin_amdgcn_s_barrier()
#define PG8_SCHED __builtin_amdgcn_sched_barrier(0)
    Unit cur, nxt; int ui = 0;
    if (!S.next(0, cur)) return;
    f32x4 acc[2][2][4][2];
#pragma unroll
    for (int a = 0; a < 2; ++a)
#pragma unroll
        for (int b = 0; b < 2; ++b)
#pragma unroll
            for (int m = 0; m < 4; ++m)
#pragma unroll
                for (int n = 0; n < 2; ++n) acc[a][b][m][n] = (f32x4){0.f, 0.f, 0.f, 0.f};
    bf16x8 At[4][2], B0[2][2], B1[2][2];
    const char* cA = (const char*)g.A + (size_t)cur.pm * tstepA; const char* cB = (const char*)g.Bt + (size_t)cur.pn * tstepB;
    S.a_ready(cur);
    if constexpr (SP2) {
        PG8_STAGE(PG8_SB(0, 0), cB, voffB); PG8_STAGE(PG8_SB(0, 1), cB + hstepB, voffB); PG8_STAGE(PG8_SA(0, 0), cA, voffA); PG8_STAGE(PG8_SA(0, 1), cA + hstepA, voffA);
        if (wr == 1) PG8_BAR;
        PG8_WAIT_V(2); PG8_BAR;
        PG8_STAGE(PG8_SB(1, 0), cB + kstep, voffB); PG8_STAGE(PG8_SA(1, 0), cA + kstep, voffA); PG8_STAGE(PG8_SB(1, 1), cB + hstepB + kstep, voffB);
        PG8_WAIT_V(6); PG8_BAR;
    } else {
        PG8_STAGE(PG8_SB(0, 0), cB, voffB); PG8_STAGE(PG8_SA(0, 0), cA, voffA); PG8_STAGE(PG8_SB(0, 1), cB + hstepB, voffB); PG8_STAGE(PG8_SA(0, 1), cA + hstepA, voffA);
        if (wr == 1) PG8_BAR;
        PG8_WAIT_V(4); PG8_BAR;
        PG8_STAGE(PG8_SB(1, 0), cB + kstep, voffB); PG8_STAGE(PG8_SA(1, 0), cA + kstep, voffA); PG8_STAGE(PG8_SB(1, 1), cB + hstepB + kstep, voffB);
        PG8_WAIT_V(6); PG8_BAR;
    }
    for (;;) {
        const bool has_next = S.next(ui + 1, nxt);
        const char* nA = has_next ? (const char*)g.A + (size_t)nxt.pm * tstepA : cA; const char* nB = has_next ? (const char*)g.Bt + (size_t)nxt.pn * tstepB : cB;
        for (int t = 0; t < nt; t += 2) {
            const bool last = (t == nt - 2);
#define PG8_KOFFA(tt) (g.a_blk ? (size_t)((tt) >> g.a_sh) * (size_t)g.a_blk + (size_t)((tt) & ((1 << g.a_sh) - 1)) * kstep : (size_t)(tt) * kstep)
            const char* a1 = cA + PG8_KOFFA(t + 1);
            const char* a2 = last ? nA : cA + PG8_KOFFA(t + 2); const char* b2 = last ? nB : cB + (size_t)(t + 2) * kstep;
            const char* a3 = last ? nA + kstep : cA + PG8_KOFFA(t + 3); const char* b3 = b2 + kstep;
#undef PG8_KOFFA
            if (last && has_next) S.a_ready(nxt);
            if constexpr (SP2) {
            PG8_LDB(B0, 0, 0); PG8_LDB(B1, 0, 1); PG8_SCHED; PG8_LDA(At, 0, 0); PG8_STAGE(PG8_SA(1, 1), a1 + hstepA, voffA);
            PG8_WAIT_V(8); PG8_WAIT_L(0); PG8_BAR; PG8_MMA(0, 0, At, B0); PG8_MMA(0, 1, At, B1); PG8_BAR; PG8_SCHED;
            PG8_LDA(At, 0, 1); PG8_STAGE(PG8_SB(0, 0), b2, voffB); PG8_STAGE(PG8_SB(0, 1), b2 + hstepB, voffB); PG8_STAGE(PG8_SA(0, 0), a2, voffA);
            PG8_WAIT_V(8); PG8_WAIT_L(0); PG8_BAR; PG8_MMA(1, 0, At, B0); PG8_MMA(1, 1, At, B1); PG8_BAR; PG8_SCHED;
            PG8_LDB(B0, 1, 0); PG8_LDB(B1, 1, 1); PG8_SCHED; PG8_LDA(At, 1, 0); PG8_STAGE(PG8_SA(0, 1), a2 + hstepA, voffA);
            PG8_WAIT_V(8); PG8_WAIT_L(0); PG8_BAR; PG8_MMA(0, 0, At, B0); PG8_MMA(0, 1, At, B1); PG8_BAR; PG8_SCHED;
            PG8_LDA(At, 1, 1); PG8_STAGE(PG8_SB(1, 0), b3, voffB); PG8_STAGE(PG8_SB(1, 1), b3 + hstepB, voffB); PG8_STAGE(PG8_SA(1, 0), a3, voffA);
            PG8_WAIT_V(8); PG8_WAIT_L(0); PG8_BAR; PG8_MMA(1, 0, At, B0); PG8_MMA(1, 1, At, B1); PG8_BAR; PG8_SCHED;
            } else {
            PG8_LDB(B0, 0, 0); PG8_SCHED; PG8_LDA(At, 0, 0); PG8_STAGE(PG8_SA(1, 1), a1 + hstepA, voffA);
            PG8_WAIT_L(8); PG8_BAR; PG8_WAIT_L(0); PG8_MMA(0, 0, At, B0); PG8_BAR; PG8_SCHED;
            PG8_LDB(B1, 0, 1); PG8_STAGE(PG8_SB(0, 0), b2, voffB);
            PG8_BAR; PG8_WAIT_L(0); PG8_MMA(0, 1, At, B1); PG8_BAR;
            PG8_LDA(At, 0, 1); PG8_STAGE(PG8_SA(0, 0), a2, voffA);
            PG8_BAR; PG8_WAIT_L(0); PG8_MMA(1, 0, At, B0); PG8_BAR; PG8_SCHED;
            PG8_STAGE(PG8_SB(0, 1), b2 + hstepB, voffB);
            PG8_WAIT_V(6); PG8_BAR; PG8_MMA(1, 1, At, B1); PG8_BAR;
            PG8_LDB(B0, 1, 0); PG8_SCHED; PG8_LDA(At, 1, 0); PG8_STAGE(PG8_SA(0, 1), a2 + hstepA, voffA);
            PG8_WAIT_L(8); PG8_BAR; PG8_WAIT_L(0); PG8_MMA(0, 0, At, B0); PG8_BAR; PG8_SCHED;
            PG8_LDB(B1, 1, 1); PG8_STAGE(PG8_SB(1, 0), b3, voffB);
            PG8_BAR; PG8_WAIT_L(0); PG8_MMA(0, 1, At, B1); PG8_BAR;
            PG8_LDA(At, 1, 1); PG8_STAGE(PG8_SA(1, 0), a3, voffA);
            PG8_BAR; PG8_WAIT_L(0); PG8_MMA(1, 0, At, B0); PG8_BAR; PG8_SCHED;
            PG8_STAGE(PG8_SB(1, 1), b3 + hstepB, voffB);
            PG8_WAIT_V(6); PG8_BAR; PG8_MMA(1, 1, At, B1); PG8_BAR;
            }
        }
        if constexpr (ALIGN_EPI) { if (wr == 0) PG8_BAR; }
        if constexpr (!Epi::AFTER_DRAIN) { E(acc, cur, wr, wc, fr, fq); S.done(cur); }
        if (!has_next) break;
#pragma unroll
        for (int a = 0; a < 2; ++a)
#pragma unroll
            for (int b = 0; b < 2; ++b)
#pragma unroll
                for (int m = 0; m < 4; ++m)
#pragma unroll
                    for (int n = 0; n < 2; ++n) acc[a][b][m][n] = (f32x4){0.f, 0.f, 0.f, 0.f};
        cur = nxt; cA = nA; cB = nB; ++ui;
        if constexpr (ALIGN_EPI) { if (wr == 1) PG8_BAR; }
    }
    PG8_WAIT_V(0);
    if constexpr (!ALIGN_EPI) { if (wr == 0) PG8_BAR; }
    PG8_BAR;
    if constexpr (Epi::AFTER_DRAIN) { E.fused(acc, cur, wr, wc, fr, fq, lds, wid, lane); S.done(cur); }
#undef PG8_SA
#undef PG8_SB
#undef PG8_STAGE
#undef PG8_LDA
#undef PG8_LDB
#undef PG8_MMA
#undef PG8_WAIT_V
#undef PG8_WAIT_L
#undef PG8_BAR
#undef PG8_SCHED
}
}
#include <hip/hip_cooperative_groups.h>
namespace cg = cooperative_groups;
#ifndef MK_MULTI
#define MK_MULTI 0
#endif
#define LAS __attribute__((address_space(3)))
typedef unsigned short bf16;
typedef float f32x4 __attribute__((ext_vector_type(4)));
typedef float f32x2 __attribute__((ext_vector_type(2)));
typedef unsigned u32x4 __attribute__((ext_vector_type(4)));
typedef unsigned u32x2 __attribute__((ext_vector_type(2)));
typedef short bf16x8 __attribute__((ext_vector_type(8)));
typedef short s16x4 __attribute__((ext_vector_type(4)));

constexpr int BATCH = 4, SEQ = 4096, M = BATCH * SEQ, D = 2048, FF = 5632, PLE = 256, GW = 4096, NQH = 32, NKV = 4, HD = 64, QKVW = 2560;
constexpr int NPHASE = 18;
constexpr size_t MiB = 1u << 20;
constexpr size_t WS_ROPE = 1 * MiB, WS_SS0 = 2 * MiB, WS_SS1 = 4 * MiB, WS_VSTAT = 6 * MiB, WS_PB = 16 * MiB, WS_XB0 = 32 * MiB, WS_XB1 = 96 * MiB, WS_PJ = 160 * MiB, WS_BIG = 224 * MiB;
constexpr size_t WS_W13 = 480 * MiB, SZ_W13 = (size_t)2 * FF * D * 2;
constexpr size_t WS_W2 = WS_W13 + 4 * SZ_W13, SZ_W2 = (size_t)D * FF * 2;
constexpr size_t WS_WG = WS_W2 + 4 * SZ_W2, SZ_WG = (size_t)D * D * 2;
constexpr size_t WS_WP = WS_WG + 2 * SZ_WG, SZ_WP = (size_t)D * PLE * 2;
constexpr size_t WS_WIN = WS_WP + 2 * SZ_WP, WS_WOUT = WS_WIN + (size_t)2 * GW * D * 2, WS_WQKV = WS_WOUT + (size_t)D * GW * 2, WS_WO = WS_WQKV + (size_t)QKVW * D * 2, WS_END = WS_WO + (size_t)D * D * 2;
constexpr int LDS_BYTES = 135168;
constexpr int MISC_OFF = 131072;
constexpr size_t WS_CTL = 0;

__device__ __forceinline__ unsigned f2bf(float f) { unsigned u = __builtin_bit_cast(unsigned, f); return (u + 0x7fffu + ((u >> 16) & 1u)) >> 16; }
__device__ __forceinline__ unsigned pk2(float lo, float hi) { return f2bf(lo) | (f2bf(hi) << 16); }
__device__ __forceinline__ float bflo(unsigned w) { return __uint_as_float(w << 16); }
__device__ __forceinline__ float bfhi(unsigned w) { return __uint_as_float(w & 0xffff0000u); }
__device__ __forceinline__ float wave_sum(float v) {
#pragma unroll
    for (int o = 1; o < 64; o <<= 1) v += __shfl_xor(v, o);
    return v;
}
#define LDS_WAIT() asm volatile("s_waitcnt lgkmcnt(0)" ::: "memory")

struct Args { const float* in[30]; float* out; unsigned char* ws; float invf[8]; int lo, hi; };

struct CvDesc { const float* src; bf16* dst; const float* gain; int K, N, mode, off, r; };
__device__ __forceinline__ void cv_load(const CvDesc& d, int lane, f32x4 (&v)[16], f32x4& g0, f32x4& g1) {
    const int nblk = d.N / 64, kb = d.r / nblk, nb = d.r % nblk, k0 = 64 * kb, n0 = 64 * nb;
    const int lk = lane >> 4, n4 = (lane & 15) * 4, c = lane & 7;
#pragma unroll
    for (int j = 0; j < 16; ++j) v[j] = __builtin_nontemporal_load((const f32x4*)(d.src + (size_t)(k0 + 4 * j + lk) * d.N + n0 + n4));
    g0 = (f32x4){1.f, 1.f, 1.f, 1.f}; g1 = g0;
    if (d.gain) { g0 = *(const f32x4*)(d.gain + k0 + 8 * c); g1 = *(const f32x4*)(d.gain + k0 + 8 * c + 4); }
}
__device__ __forceinline__ void cv_process(const CvDesc& d, int lane, const f32x4 (&v)[16], const f32x4& g0, const f32x4& g1, LAS float* scr) {
    const int nblk = d.N / 64, kb = d.r / nblk, nb = d.r % nblk, k0 = 64 * kb, n0 = 64 * nb;
    const int lk = lane >> 4, n4 = (lane & 15) * 4, c = lane & 7;
#pragma unroll
    for (int j = 0; j < 16; ++j) { const int k = 4 * j + lk; *(LAS f32x4*)(scr + k * 64 + (n4 ^ (8 * ((k >> 3) & 7)))) = v[j]; }
    LDS_WAIT(); asm volatile("" ::: "memory");
#pragma unroll
    for (int j = 0; j < 8; ++j) { const int n = (lane >> 3) + 8 * j; const LAS float* s = scr + (8 * c) * 64 + (n ^ (8 * c));
        u32x4 o; o.x = pk2(s[0 * 64] * g0[0], s[1 * 64] * g0[1]); o.y = pk2(s[2 * 64] * g0[2], s[3 * 64] * g0[3]); o.z = pk2(s[4 * 64] * g1[0], s[5 * 64] * g1[1]); o.w = pk2(s[6 * 64] * g1[2], s[7 * 64] * g1[3]);
        const int ng = n0 + n, drow = d.mode ? (((ng >> 7) << 8) + (ng & 127) + d.off) : (d.off + ng);
        *(u32x4*)(d.dst + (size_t)drow * d.K + k0 + 8 * c) = o; }
    LDS_WAIT(); asm volatile("" ::: "memory");
}
constexpr int CV_UP = (D / 64) * (FF / 64), CV_DN = (FF / 64) * (D / 64), CV_DD = (D / 64) * (D / 64), CV_PJ = (PLE / 64) * (D / 64), CV_IN = (D / 64) * (2 * GW / 64), CV_OUT = (GW / 64) * (D / 64), CV_KV = (D / 64) * (256 / 64);
constexpr int CV_LAYER = 4 * CV_UP + 2 * CV_DN + CV_DD + CV_PJ;
constexpr int CV_EARLY = CV_LAYER + 2 * CV_UP + CV_DN + CV_IN + CV_OUT + CV_DD + 2 * CV_KV;
constexpr int CV_ALL = 2 * CV_LAYER + CV_IN + CV_OUT + 2 * CV_DD + 2 * CV_KV;
__device__ __forceinline__ CvDesc cv_decode(const Args& a, int it) {
    unsigned char* ws = a.ws;
    int r = it; CvDesc d; d.src = nullptr; d.dst = nullptr; d.gain = nullptr; d.K = 64; d.N = 64; d.mode = 0; d.off = 0; d.r = 0; bool hit = false;
#define JOB(CNT, SRC, KK, NN, DST, GAIN, MODE, OFF) if (!hit) { if (r < (CNT)) { d.src = (SRC); d.K = (KK); d.N = (NN); d.dst = (bf16*)(DST); d.gain = (GAIN); d.mode = (MODE); d.off = (OFF); d.r = r; hit = true; } else r -= (CNT); }
#define FFN_JOBS(F, L, IW1, IW3, IW2, INORM) \
    JOB(CV_UP, a.in[IW1] + (size_t)(L) * D * FF, D, FF, ws + WS_W13 + (size_t)((F) * 2 + (L)) * SZ_W13, a.in[INORM] + (L) * D, 1, 0) \
    JOB(CV_UP, a.in[IW3] + (size_t)(L) * D * FF, D, FF, ws + WS_W13 + (size_t)((F) * 2 + (L)) * SZ_W13, a.in[INORM] + (L) * D, 1, 128) \
    JOB(CV_DN, a.in[IW2] + (size_t)(L) * D * FF, FF, D, ws + WS_W2 + (size_t)((F) * 2 + (L)) * SZ_W2, nullptr, 0, 0)
#define PLE_JOBS(L) \
    JOB(CV_DD, a.in[12] + (size_t)(L) * D * D, D, D, ws + WS_WG + (size_t)(L) * SZ_WG, a.in[11] + (L) * D, 0, 0) \
    JOB(CV_PJ, a.in[13] + (size_t)(L) * PLE * D, PLE, D, ws + WS_WP + (size_t)(L) * SZ_WP, nullptr, 0, 0)
    FFN_JOBS(0, 0, 3, 4, 5, 2) FFN_JOBS(1, 0, 8, 9, 10, 7) PLE_JOBS(0)
    FFN_JOBS(0, 1, 3, 4, 5, 2)
    JOB(CV_IN, a.in[14], D, 2 * GW, ws + WS_WIN, a.in[6], 0, 0)
    JOB(CV_OUT, a.in[19], GW, D, ws + WS_WOUT, nullptr, 0, 0)
    JOB(CV_DD, a.in[20], D, D, ws + WS_WQKV, a.in[6] + D, 0, 0)
    JOB(CV_KV, a.in[22], D, 256, ws + WS_WQKV, a.in[6] + D, 0, 2048)
    JOB(CV_KV, a.in[24], D, 256, ws + WS_WQKV, a.in[6] + D, 0, 2304)
    FFN_JOBS(1, 1, 8, 9, 10, 7) PLE_JOBS(1)
    JOB(CV_DD, a.in[27], D, D, ws + WS_WO, nullptr, 0, 0)
#undef PLE_JOBS
#undef FFN_JOBS
#undef JOB
    return d;
}
__device__ __forceinline__ void convert_items(const Args& a, LAS unsigned char* lds, int first, int last, int worker, int nworkers) {
    const int tid = threadIdx.x, lane = tid & 63, wave = tid >> 6;
    LAS float* scr = (LAS float*)(lds + wave * 16384);
    int it = first + worker; if (it >= last) return;
    CvDesc d0 = cv_decode(a, it), d1 = d0; f32x4 va[16], vb[16], ga0, ga1, gb0, gb1;
    cv_load(d0, lane, va, ga0, ga1);
    for (;;) {
        const int it1 = it + nworkers; const bool h1 = it1 < last;
        if (h1) { d1 = cv_decode(a, it1); cv_load(d1, lane, vb, gb0, gb1); }
        cv_process(d0, lane, va, ga0, ga1, scr);
        if (!h1) break;
        const int it2 = it1 + nworkers; const bool h2 = it2 < last;
        if (h2) { d0 = cv_decode(a, it2); cv_load(d0, lane, va, ga0, ga1); }
        cv_process(d1, lane, vb, gb0, gb1, scr);
        if (!h2) break;
        it = it2;
    }
}
__device__ __forceinline__ void p0_prologue(const Args& a, LAS unsigned char* lds) {
    const int tid = threadIdx.x, lane = tid & 63, wave = tid >> 6, G = gridDim.x;
    const int gw = blockIdx.x * 8 + wave, NGW = G * 8;
    unsigned char* ws = a.ws;
    convert_items(a, lds, 0, CV_ALL, gw, NGW);
    { const float* x = a.in[0]; bf16* xb = (bf16*)(ws + WS_XB0); float* ss0 = (float*)(ws + WS_SS0);
      for (int m = gw; m < M; m += NGW) { const f32x4* xr = (const f32x4*)(x + (size_t)m * D) + lane; u32x2* o8 = (u32x2*)(xb + (size_t)(m >> 8) * 8 * 65536 + (size_t)(m & 255) * 256) + lane; float s = 0.f;
#pragma unroll
          for (int j = 0; j < 8; ++j) { const f32x4 v = __builtin_nontemporal_load(xr + 64 * j); s += (v[0] * v[0] + v[1] * v[1]) + (v[2] * v[2] + v[3] * v[3]); u32x2 w; w.x = pk2(v[0], v[1]); w.y = pk2(v[2], v[3]); o8[(size_t)j * (65536 / 4)] = w; }
          s = wave_sum(s); if (lane < 32) ss0[(size_t)m * 32 + lane] = lane == 0 ? s : 0.f; } }
    { const float* p = a.in[1]; bf16* pb = (bf16*)(ws + WS_PB); const size_t n8 = (size_t)2 * M * PLE / 8;
      for (size_t i = (size_t)blockIdx.x * 512 + tid; i < n8; i += (size_t)G * 512) { const f32x4 v0 = *(const f32x4*)(p + i * 8), v1 = *(const f32x4*)(p + i * 8 + 4);
          u32x4 w; w.x = pk2(v0[0], v0[1]); w.y = pk2(v0[2], v0[3]); w.z = pk2(v1[0], v1[1]); w.w = pk2(v1[2], v1[3]); *(u32x4*)(pb + i * 8) = w; } }
    { f32x2* rt = (f32x2*)(ws + WS_ROPE);
      for (int i = blockIdx.x * 512 + tid; i < SEQ * 8; i += G * 512) { const int pos = i >> 3, j = i & 7;
          const float ang = __fmul_rn((float)pos, a.invf[j]); const double rev = (double)ang * 0.15915494309189535; const float fr = (float)(rev - __builtin_rint(rev));
          rt[i] = (f32x2){__builtin_amdgcn_cosf(fr), __builtin_amdgcn_sinf(fr)}; } }
}

__device__ __forceinline__ s16x4 tr_read(const LAS bf16* p) { return __builtin_bit_cast(s16x4, __builtin_amdgcn_ds_read_tr16_b64_v4i16((LAS s16x4*)p)); }

#define XB_TMO      128
#define XB_XCNT(j)  (256  + 64 * (j))
#define XB_XSUB(j)  (1280 + 64 * (j))
#define XB_XGEN(j)  (2304 + 64 * (j))
#define XB_TOP      3328
#define XB_TOPGEN   3392
#define XCD_BAR_WORDS 3456
#define XB_SPIN_CAP (1u << 18)

__device__ __forceinline__ unsigned xb_ld(unsigned* p)              { return __hip_atomic_load(p, __ATOMIC_RELAXED, __HIP_MEMORY_SCOPE_AGENT); }
__device__ __forceinline__ unsigned xb_add(unsigned* p, unsigned v) { return __hip_atomic_fetch_add(p, v, __ATOMIC_RELAXED, __HIP_MEMORY_SCOPE_AGENT); }
__device__ __forceinline__ unsigned xb_xcc_id() { return (unsigned)__builtin_amdgcn_s_getreg((3 << 11) | 20) & 0xFu; }
#define XB_SPIN(cond, bar) do { unsigned _sp = 0; while (cond) { __builtin_amdgcn_s_sleep(1); \
    if ((++_sp & 255u) == 0u) { if (xb_ld(&(bar)[XB_TMO])) break; if (_sp > XB_SPIN_CAP) { atomicAdd(&(bar)[XB_TMO], 1u); break; } } } } while (0)

struct XcdBarrier {
    unsigned* bar; unsigned x;
    volatile LAS unsigned* st;
};

__device__ __forceinline__ XcdBarrier xcd_barrier_post(unsigned* bar, volatile LAS unsigned* st) {
    XcdBarrier b; b.bar = bar; b.x = xb_xcc_id(); b.st = st;
    if (threadIdx.x == 0) (void)xb_add(&bar[XB_XCNT(b.x)], 1u);
    return b;
}
__device__ __forceinline__ void xcd_barrier_complete(unsigned* bar, unsigned x, unsigned& nloc, unsigned& nx) {
    const unsigned G = gridDim.x * gridDim.y * gridDim.z;
    unsigned sum, cnt, mine, sp = 0u;
    for (;;) {
        sum = 0u; cnt = 0u; mine = 0u;
#pragma unroll
        for (unsigned j = 0; j < 16; ++j) { const unsigned c = xb_ld(&bar[XB_XCNT(j)]); sum += c; cnt += (c > 0u) ? 1u : 0u; mine = (j == x) ? c : mine; }
        if (sum == G) break;
        __builtin_amdgcn_s_sleep(1);
        if ((++sp & 255u) == 0u) { if (xb_ld(&bar[XB_TMO])) break; if (sp > XB_SPIN_CAP) { atomicAdd(&bar[XB_TMO], 1u); break; } }
    }
    nloc = mine > 0u ? mine : 1u; nx = cnt > 0u ? cnt : 1u;
}

__device__ __forceinline__ void xcd_barrier(const XcdBarrier& b) {
    asm volatile("s_waitcnt vmcnt(0)" ::: "memory");
    __syncthreads();
    if (threadIdx.x == 0) {
        unsigned* bar = b.bar;
        __builtin_amdgcn_s_waitcnt(0);
        unsigned nloc = b.st[0], nx = b.st[1];
        if (nloc == 0u) { xcd_barrier_complete(bar, b.x, nloc, nx); b.st[0] = nloc; b.st[1] = nx; }
        const unsigned old = xb_add(&bar[XB_XSUB(b.x)], 1u);
        const unsigned gen = old / nloc;
        if (old + 1u == (gen + 1u) * nloc) {
            __builtin_amdgcn_fence(__ATOMIC_RELEASE, "agent");
            asm volatile("s_waitcnt vmcnt(0)" ::: "memory");
            const unsigned og = xb_add(&bar[XB_TOP], 1u);
            const unsigned tg = og / nx;
            if (og + 1u == (tg + 1u) * nx) xb_add(&bar[XB_TOPGEN], 1u);
            else XB_SPIN(xb_ld(&bar[XB_TOPGEN]) == tg, bar);
            __builtin_amdgcn_fence(__ATOMIC_ACQUIRE, "agent");
            xb_add(&bar[XB_XGEN(b.x)], 1u);
            asm volatile("s_waitcnt vmcnt(0)" ::: "memory");
        } else {
            XB_SPIN(xb_ld(&bar[XB_XGEN(b.x)]) == gen, bar);
            __builtin_amdgcn_fence(__ATOMIC_ACQUIRE, "agent");
            asm volatile("s_waitcnt vmcnt(0)" ::: "memory");
        }
    }
    __syncthreads();
}

constexpr size_t ARENA_E = (size_t)(4u << 20) / 2;
struct Team { bool on, same; int pm, j; unsigned* cnt; unsigned* tmo; };
__device__ __forceinline__ bool team_mode() { return gridDim.x == 256; }
__device__ __forceinline__ int my_pm() { const int c = blockIdx.x; return 8 * (c & 7) + ((c >> 3) & 7); }
__device__ __forceinline__ size_t panel_adj(int pm, int ld) { return team_mode() ? (size_t)pm * (ARENA_E - (size_t)256 * ld) : 0; }
__device__ __forceinline__ size_t arena_adj(int ld) { return panel_adj(my_pm(), ld); }
__device__ __forceinline__ size_t h_pstride() { return team_mode() ? ARENA_E : (size_t)(FF / 128) * 32768; }
__device__ __forceinline__ void team_barrier(const Team& T) {
    asm volatile("s_waitcnt vmcnt(0)" ::: "memory");
    __syncthreads();
    if (threadIdx.x == 0) {
        __builtin_amdgcn_s_waitcnt(0);
        if (!T.same) { __builtin_amdgcn_fence(__ATOMIC_RELEASE, "agent"); asm volatile("s_waitcnt vmcnt(0)" ::: "memory"); }
        const unsigned old = xb_add(T.cnt, 1u), target = (old / 4u + 1u) * 4u;
        XB_SPIN(xb_ld(T.cnt) < target, T.tmo);
        __builtin_amdgcn_fence(__ATOMIC_ACQUIRE, "agent");
        asm volatile("s_waitcnt vmcnt(0)" ::: "memory");
    }
    __syncthreads();
}
__device__ __forceinline__ void spatial_phase(LAS unsigned char* lds, const bf16* Z, bf16* GT, const float* vstat, const float* lng, const float* lnb, const float* wsp, const float* bsp) {
    const int tid = threadIdx.x, lane = tid & 63, wid = tid >> 6, fr = lane & 15, fq = lane >> 4, q4 = (lane & 15) >> 2, p4 = lane & 3;
    constexpr int WP = 136, VP = 272;
    LAS bf16* Wl = (LAS bf16*)lds;
    LAS bf16* Vl = (LAS bf16*)(lds + 128 * WP * 2);
    LAS float* MU = (LAS float*)(lds + 128 * WP * 2 + 128 * VP * 2);
    LAS float* RS = MU + 128;
    const int th = wid >> 2, cq = wid & 3;
    const int NUNIT = (M / 128) * 16;
    if ((int)blockIdx.x >= NUNIT) return;
    int g = -1; const int c8 = (tid & 31) * 8; int ch = 0;
    f32x4 g0, g1, b0, b1; float bsv[4];
#define SP_STAGE_G(GG) do { g = (GG); ch = g * 256 + c8; const float* wg_ = wsp + (size_t)g * 128 * 128; \
        _Pragma("unroll") for (int j = 0; j < 8; ++j) { const int e = tid + 512 * j, t = e >> 5, s4 = (e & 31) * 4; f32x4 v = *(const f32x4*)(wg_ + t * 128 + s4); \
            _Pragma("unroll") for (int k = 0; k < 4; ++k) if (s4 + k > t) v[k] = 0.f; \
            u32x2 w; w.x = pk2(v[0], v[1]); w.y = pk2(v[2], v[3]); *(LAS u32x2*)(Wl + t * WP + s4) = w; } \
        g0 = *(const f32x4*)(lng + ch); g1 = *(const f32x4*)(lng + ch + 4); b0 = *(const f32x4*)(lnb + ch); b1 = *(const f32x4*)(lnb + ch + 4); \
        _Pragma("unroll") for (int tt = 0; tt < 4; ++tt) bsv[tt] = bsp[g * 128 + th * 64 + tt * 16 + fr]; } while (0)
    for (int idx = blockIdx.x; idx < NUNIT; idx += gridDim.x) {
        const int chunk = idx >> 4; const size_t rowb = (size_t)chunk * 128;
        const size_t zpan = (size_t)(chunk >> 1) * 2097152; const int zrow = (chunk & 1) * 128;
        if ((idx & 15) != g) SP_STAGE_G(idx & 15);
        u32x4 vw[8]; float s1 = 0.f, s2 = 0.f;
        { const int row = tid >> 2, qq = tid & 3; const f32x4* sp = (const f32x4*)(vstat + ((rowb + row) * 64 + qq * 16) * 2);
          f32x4 sv[8];
#pragma unroll
          for (int j = 0; j < 8; ++j) sv[j] = sp[j];
#pragma unroll
          for (int j = 0; j < 8; ++j) vw[j] = *(const u32x4*)(Z + zpan + (size_t)(16 + g) * 65536 + (size_t)(zrow + (tid >> 5) + 16 * j) * 256 + c8);
#pragma unroll
          for (int j = 0; j < 8; ++j) { s1 += sv[j][0] + sv[j][2]; s2 += sv[j][1] + sv[j][3]; }
          s1 += __shfl_xor(s1, 1); s1 += __shfl_xor(s1, 2); s2 += __shfl_xor(s2, 1); s2 += __shfl_xor(s2, 2);
          const float mean = s1 * (1.0f / GW), var = fmaxf(s2 * (1.0f / GW) - mean * mean, 0.f);
          if (qq == 0) { MU[row] = mean; RS[row] = __builtin_amdgcn_rsqf(var + 1e-5f); } }
        __syncthreads();
#pragma unroll
        for (int j = 0; j < 8; ++j) { const int sr = (tid >> 5) + 16 * j; const u32x4 w = vw[j]; const float mu = MU[sr], rs = RS[sr];
            f32x4 v0 = (f32x4){bflo(w.x), bfhi(w.x), bflo(w.y), bfhi(w.y)}, v1 = (f32x4){bflo(w.z), bfhi(w.z), bflo(w.w), bfhi(w.w)};
            v0 = (v0 - mu) * rs * g0 + b0; v1 = (v1 - mu) * rs * g1 + b1;
            u32x4 o; o.x = pk2(v0[0], v0[1]); o.y = pk2(v0[2], v0[3]); o.z = pk2(v1[0], v1[1]); o.w = pk2(v1[2], v1[3]); *(LAS u32x4*)(Vl + sr * VP + c8) = o; }
        u32x2 uw[4][4];
#pragma unroll
        for (int tt = 0; tt < 4; ++tt)
#pragma unroll
            for (int ct = 0; ct < 4; ++ct) uw[tt][ct] = *(const u32x2*)(Z + zpan + (size_t)g * 65536 + (size_t)(zrow + th * 64 + tt * 16 + fr) * 256 + cq * 64 + ct * 16 + 4 * fq);
        __syncthreads();
        f32x4 acc[4][4];
#pragma unroll
        for (int i = 0; i < 4; ++i)
#pragma unroll
            for (int j = 0; j < 4; ++j) acc[i][j] = (f32x4){0.f, 0.f, 0.f, 0.f};
#pragma unroll
        for (int ks = 0; ks < 4; ++ks) {
            bf16x8 wf[4], vf[4];
#pragma unroll
            for (int tt = 0; tt < 4; ++tt) wf[tt] = *(const LAS bf16x8*)(Wl + (th * 64 + tt * 16 + fr) * WP + ks * 32 + fq * 8);
#pragma unroll
            for (int ct = 0; ct < 4; ++ct) { const LAS bf16* vp = Vl + (ks * 32 + 8 * fq + q4) * VP + cq * 64 + ct * 16 + 4 * p4;
                const s16x4 lo = tr_read(vp), hi = tr_read(vp + 4 * VP); vf[ct] = (bf16x8){lo[0], lo[1], lo[2], lo[3], hi[0], hi[1], hi[2], hi[3]}; }
#pragma unroll
            for (int ct = 0; ct < 4; ++ct)
#pragma unroll
                for (int tt = 0; tt < 4; ++tt) acc[ct][tt] = __builtin_amdgcn_mfma_f32_16x16x32_bf16(vf[ct], wf[tt], acc[ct][tt], 0, 0, 0);
        }
#pragma unroll
        for (int tt = 0; tt < 4; ++tt) { const int t = th * 64 + tt * 16 + fr; const float bv_ = bsv[tt];
#pragma unroll
            for (int ct = 0; ct < 4; ++ct) { const u32x2 w = uw[tt][ct]; bf16* up = GT + zpan + (size_t)g * 65536 + (size_t)(zrow + t) * 256 + cq * 64 + ct * 16 + 4 * fq;
                u32x2 o; o.x = pk2(bflo(w.x) * (acc[ct][tt][0] + bv_), bfhi(w.x) * (acc[ct][tt][1] + bv_)); o.y = pk2(bflo(w.y) * (acc[ct][tt][2] + bv_), bfhi(w.y) * (acc[ct][tt][3] + bv_)); *(u32x2*)up = o; } }
        __syncthreads();
    }
#undef SP_STAGE_G
}

__device__ __forceinline__ void attn_phase(LAS unsigned char* lds, const bf16* QKV, bf16* O, const float* rope, const float* sinks) {
    const size_t adjq = team_mode() ? ARENA_E - (size_t)256 * QKVW : 0, adjo = team_mode() ? ARENA_E - (size_t)256 * D : 0;
    const int tid = threadIdx.x, lane = tid & 63, wid = tid >> 6, fr = lane & 15, fq = lane >> 4, q4 = (lane & 15) >> 2, p4 = lane & 3;
    constexpr int KP = 72;
    LAS bf16* Kl = (LAS bf16*)lds;
    LAS bf16* Vl = (LAS bf16*)(lds + 272 * KP * 2);
    constexpr int NB = SEQ / 128, NU = BATCH * NB * NKV;
    const int r = tid >> 1, half = tid & 1;
    if (tid < 32) {
#pragma unroll
        for (int c = 0; c < 4; ++c) { *(LAS u32x4*)(Kl + (256 + r) * KP + half * 32 + 8 * c) = (u32x4){0u, 0u, 0u, 0u}; *(LAS u32x4*)(Vl + (256 + r) * KP + half * 32 + 8 * c) = (u32x4){0u, 0u, 0u, 0u}; } }
    u32x4 kw[4], vw[4]; f32x4 kr[4];
#define ATT_LOAD_KV(IDX) do { const int kh_ = (IDX) & 3, nb_ = ((IDX) >> 2) % NB, b_ = (IDX) / (4 * NB); const int pos_ = (nb_ - 1) * 128 + r; \
        if (pos_ >= 0) { const size_t krow_ = (size_t)b_ * SEQ + pos_; const bf16* kp_ = QKV + krow_ * QKVW + (krow_ >> 8) * adjq + 2048 + kh_ * 64 + half * 32; \
            _Pragma("unroll") for (int c = 0; c < 4; ++c) { kw[c] = *(const u32x4*)(kp_ + 8 * c); vw[c] = *(const u32x4*)(kp_ + 256 + 8 * c); } \
            const f32x4* rp_ = (const f32x4*)(rope + (size_t)pos_ * 16); _Pragma("unroll") for (int c = 0; c < 4; ++c) kr[c] = rp_[c]; \
        } else { _Pragma("unroll") for (int c = 0; c < 4; ++c) { kw[c] = (u32x4){0u, 0u, 0u, 0u}; vw[c] = (u32x4){0u, 0u, 0u, 0u}; kr[c] = (f32x4){1.f, 0.f, 1.f, 0.f}; } } } while (0)
    int idx = blockIdx.x;
    if (idx < NU) ATT_LOAD_KV(idx);
    while (idx < NU) {
        const int kh = idx & 3, nb = (idx >> 2) % NB, b = idx / (4 * NB);
        { if (half == 0) {
              const float cs[8] = {kr[0][0], kr[0][2], kr[1][0], kr[1][2], kr[2][0], kr[2][2], kr[3][0], kr[3][2]}, sn[8] = {kr[0][1], kr[0][3], kr[1][1], kr[1][3], kr[2][1], kr[2][3], kr[3][1], kr[3][3]};
              float x1[8], x2[8];
#pragma unroll
              for (int e = 0; e < 4; ++e) { x1[2 * e] = bflo(kw[0][e]); x1[2 * e + 1] = bfhi(kw[0][e]); x2[2 * e] = bflo(kw[1][e]); x2[2 * e + 1] = bfhi(kw[1][e]); }
#pragma unroll
              for (int e = 0; e < 4; ++e) { kw[0][e] = pk2(x1[2 * e] * cs[2 * e] - x2[2 * e] * sn[2 * e], x1[2 * e + 1] * cs[2 * e + 1] - x2[2 * e + 1] * sn[2 * e + 1]);
                                            kw[1][e] = pk2(x2[2 * e] * cs[2 * e] + x1[2 * e] * sn[2 * e], x2[2 * e + 1] * cs[2 * e + 1] + x1[2 * e + 1] * sn[2 * e + 1]); } }
#pragma unroll
          for (int c = 0; c < 4; ++c) { *(LAS u32x4*)(Kl + r * KP + half * 32 + 8 * c) = kw[c]; *(LAS u32x4*)(Vl + r * KP + half * 32 + 8 * c) = vw[c]; } }
        __syncthreads();
        const int nidx = idx + gridDim.x;
        if (nidx < NU) ATT_LOAD_KV(nidx);
        const int qh = kh * 8 + wid; const float sink = sinks[qh];
        const size_t qrow0 = (size_t)b * SEQ + nb * 128 + fr;
        u32x4 qw0, qw1; f32x4 qr[4];
#define ATT_LOAD_Q(A) do { const size_t qrw_ = qrow0 + (A) * 16; const bf16* qp_ = QKV + qrw_ * QKVW + (qrw_ >> 8) * adjq + qh * 64 + fq * 8; qw0 = *(const u32x4*)qp_; qw1 = *(const u32x4*)(qp_ + 32); \
        const f32x4* rp_ = (const f32x4*)(rope + (size_t)(nb * 128 + (A) * 16 + fr) * 16); _Pragma("unroll") for (int c = 0; c < 4; ++c) qr[c] = rp_[c]; } while (0)
        ATT_LOAD_Q(0);
        for (int a = 0; a < 8; ++a) {
            const int qi = a * 16 + fr; const size_t qrow = qrow0 + a * 16;
            bf16x8 qf[2];
            { u32x4 w0 = qw0; const u32x4 w1 = qw1;
              const float cs[8] = {qr[0][0], qr[0][2], qr[1][0], qr[1][2], qr[2][0], qr[2][2], qr[3][0], qr[3][2]}, sn[8] = {qr[0][1], qr[0][3], qr[1][1], qr[1][3], qr[2][1], qr[2][3], qr[3][1], qr[3][3]};
              u32x4 pw; pw.x = __shfl_xor(w0.x, 16); pw.y = __shfl_xor(w0.y, 16); pw.z = __shfl_xor(w0.z, 16); pw.w = __shfl_xor(w0.w, 16);
              const float sg = fq == 0 ? -1.f : 1.f;
              u32x4 rw;
#pragma unroll
              for (int e = 0; e < 4; ++e) { const float xa = bflo(w0[e]), xb = bfhi(w0[e]), pa = bflo(pw[e]), pb = bfhi(pw[e]);
                  rw[e] = pk2(xa * cs[2 * e] + sg * pa * sn[2 * e], xb * cs[2 * e + 1] + sg * pb * sn[2 * e + 1]); }
              if (fq < 2) w0 = rw;
              qf[0] = __builtin_bit_cast(bf16x8, w0); qf[1] = __builtin_bit_cast(bf16x8, w1); }
            if (a < 7) ATT_LOAD_Q(a + 1);
            f32x4 sc[10];
#pragma unroll
            for (int j = 0; j < 10; ++j) { const LAS bf16* kp = Kl + ((a + j) * 16 + fr) * KP + fq * 8;
                f32x4 z = (f32x4){0.f, 0.f, 0.f, 0.f};
                z = __builtin_amdgcn_mfma_f32_16x16x32_bf16(*(const LAS bf16x8*)kp, qf[0], z, 0, 0, 0);
                z = __builtin_amdgcn_mfma_f32_16x16x32_bf16(*(const LAS bf16x8*)(kp + 32), qf[1], z, 0, 0, 0);
                sc[j] = z; }
            const int qpos = 128 + qi; float mx = -INFINITY;
#pragma unroll
            for (int j = 0; j < 10; ++j)
#pragma unroll
                for (int e = 0; e < 4; ++e) { const int kpos = (a + j) * 16 + 4 * fq + e; const bool valid = (kpos <= qpos) && (kpos > qpos - 128) && (nb > 0 || kpos >= 128);
                    const float sv = valid ? sc[j][e] * 0.125f : -INFINITY; sc[j][e] = sv; mx = fmaxf(mx, sv); }
            mx = fmaxf(mx, __shfl_xor(mx, 16)); mx = fmaxf(mx, __shfl_xor(mx, 32)); mx = fmaxf(mx, sink);
            float l = 0.f;
#pragma unroll
            for (int j = 0; j < 10; ++j)
#pragma unroll
                for (int e = 0; e < 4; ++e) { const float p = __expf(sc[j][e] - mx); sc[j][e] = p; l += p; }
            l += __shfl_xor(l, 16); l += __shfl_xor(l, 32); l += __expf(sink - mx);
            const float rl = 1.0f / l;
            f32x4 oacc[4];
#pragma unroll
            for (int c = 0; c < 4; ++c) oacc[c] = (f32x4){0.f, 0.f, 0.f, 0.f};
#pragma unroll
            for (int j2 = 0; j2 < 5; ++j2) {
                u32x4 pwv; pwv.x = pk2(sc[2 * j2][0], sc[2 * j2][1]); pwv.y = pk2(sc[2 * j2][2], sc[2 * j2][3]); pwv.z = pk2(sc[2 * j2 + 1][0], sc[2 * j2 + 1][1]); pwv.w = pk2(sc[2 * j2 + 1][2], sc[2 * j2 + 1][3]);
                const bf16x8 pf = __builtin_bit_cast(bf16x8, pwv);
#pragma unroll
                for (int c = 0; c < 4; ++c) { const LAS bf16* vp = Vl + ((a + 2 * j2) * 16 + 4 * fq + q4) * KP + 16 * c + 4 * p4;
                    const s16x4 lo = tr_read(vp), hi = tr_read(vp + 16 * KP);
                    const bf16x8 vf = (bf16x8){lo[0], lo[1], lo[2], lo[3], hi[0], hi[1], hi[2], hi[3]};
                    oacc[c] = __builtin_amdgcn_mfma_f32_16x16x32_bf16(vf, pf, oacc[c], 0, 0, 0); }
            }
            bf16* op = O + qrow * D + (qrow >> 8) * adjo + qh * 64 + 4 * fq;
#pragma unroll
            for (int c = 0; c < 4; ++c) { u32x2 w; w.x = pk2(oacc[c][0] * rl, oacc[c][1] * rl); w.y = pk2(oacc[c][2] * rl, oacc[c][3] * rl); *(u32x2*)(op + 16 * c) = w; }
        }
        __syncthreads();
        idx = nidx;
    }
#undef ATT_LOAD_KV
#undef ATT_LOAD_Q
}

__device__ __forceinline__ void final_phase(float* x, const float* ssq, const float* gn, bool team) {
    const int tid = threadIdx.x, lane = tid & 63, wave = tid >> 6; const int gw = blockIdx.x * 8 + wave, NGW = gridDim.x * 8;
    const int mbeg = team ? my_pm() * 256 + (int)(blockIdx.x >> 6) * 64 + wave : gw, mend = team ? my_pm() * 256 + (int)(blockIdx.x >> 6) * 64 + 64 : M, mstep = team ? 8 : NGW;
    for (int m = mbeg; m < mend; m += mstep) { float s = ssq[(size_t)m * 32 + (lane & 31)];
#pragma unroll
        for (int o = 1; o < 32; o <<= 1) s += __shfl_xor(s, o);
        const float rs = __builtin_amdgcn_rsqf(s * (1.0f / D) + 1e-6f); f32x4* xr = (f32x4*)(x + (size_t)m * D) + lane; const f32x4* gr = (const f32x4*)gn + lane;
#pragma unroll
        for (int j = 0; j < 8; ++j) xr[64 * j] = xr[64 * j] * rs * gr[64 * j]; }
}

__device__ __forceinline__ const LAS float* stage_rstd(LAS unsigned char* lds, const float* ssqp, int N) {
    if (gridDim.x != 256) return nullptr;
    pg8::StaticOrder S; S.init(M, N, 256, blockIdx.x); pg8::Unit u; if (!S.next(0, u)) return nullptr;
    LAS float* RS = (LAS float*)(lds + 131072 + 2048);
    const int t = threadIdx.x;
    if (t < 256) { const f32x4* p = (const f32x4*)(ssqp + (size_t)(u.pm * 256 + t) * 32); float sm = 0.f;
#pragma unroll
        for (int j = 0; j < 8; ++j) { const f32x4 v = p[j]; sm += (v[0] + v[1]) + (v[2] + v[3]); }
        RS[t] = __builtin_amdgcn_rsqf(sm * (1.0f / D) + 1e-6f); }
    __syncthreads();
    return RS;
}
#define IN(k) (lo <= (k) && (k) < hi)
#define SEAM(k) do { if (IN(k) && IN((k) + 1)) xcd_barrier(bar); } while (0)
#define SEAM_T(k) do { if (IN(k) && IN((k) + 1)) { if (T.on) team_barrier(T); else xcd_barrier(bar); } } while (0)
template <int F, int L> __device__ __forceinline__ void ph_ffn_up(const Args& a, LAS unsigned char* lds) {
    unsigned char* ws = a.ws;
    pg8::Gemm g{(const bf16*)(ws + WS_XB0), (const bf16*)(ws + WS_W13 + (size_t)(F * 2 + L) * SZ_W13), M, 2 * FF, D, 256, (size_t)256 * D * 2, 131072, 2}; pg8::StaticOrder S; S.init(M, 2 * FF, gridDim.x, blockIdx.x);
    pg8::EpiSwiGLU E{(bf16*)(ws + WS_BIG), h_pstride(), (const float*)(ws + WS_SS0), stage_rstd(lds, (const float*)(ws + WS_SS0), 2 * FF)};
    pg8::gemm_phase<pg8::EpiSwiGLU, pg8::StaticOrder, true, true>(lds, g, S, E);
}
template <int L> __device__ __forceinline__ void ph_ple_proj(const Args& a, LAS unsigned char* lds) {
    unsigned char* ws = a.ws;
    pg8::Gemm g{(const bf16*)(ws + WS_PB) + (size_t)L * M * PLE, (const bf16*)(ws + WS_WP + (size_t)L * SZ_WP), M, D, PLE, PLE}; pg8::StaticOrder S; S.init(M, D, gridDim.x, blockIdx.x);
    pg8::EpiQKV E{(bf16*)(ws + WS_PJ), D, nullptr, nullptr, nullptr, nullptr, nullptr};
    pg8::gemm_phase<pg8::EpiQKV, pg8::StaticOrder, true, true>(lds, g, S, E);
}
template <int F, int L> __device__ __forceinline__ void ph_ffn_down(const Args& a, LAS unsigned char* lds) {
    unsigned char* ws = a.ws;
    pg8::Gemm g{(const bf16*)(ws + WS_BIG), (const bf16*)(ws + WS_W2 + (size_t)(F * 2 + L) * SZ_W2), M, D, FF, 128, h_pstride() * 2, 65536, 1}; pg8::StaticOrder S; S.init(M, D, gridDim.x, blockIdx.x);
    constexpr bool FIRST = (F == 0 && L == 0);
    pg8::EpiResid<FIRST> E{a.in[0], (const bf16*)(ws + WS_XB0), (bf16*)(ws + WS_XB1), (float*)(ws + WS_SS1), nullptr, 0.5f};
    pg8::gemm_phase<pg8::EpiResid<FIRST>, pg8::StaticOrder, true, true>(lds, g, S, E);
}
template <int L> __device__ __forceinline__ void ph_mix_out(const Args& a, LAS unsigned char* lds) {
    unsigned char* ws = a.ws;
    pg8::Gemm g = (L == 0) ? pg8::Gemm{(const bf16*)(ws + WS_BIG), (const bf16*)(ws + WS_WOUT), M, D, GW, 256, (size_t)4 << 20, 131072, 2}
                           : pg8::Gemm{(const bf16*)(ws + WS_BIG) + (team_mode() ? (size_t)256 * QKVW + arena_adj(D) : (size_t)M * QKVW), (const bf16*)(ws + WS_WO), M, D, D, D};
    pg8::StaticOrder S; S.init(M, D, gridDim.x, blockIdx.x);
    pg8::EpiResid<false> E{nullptr, (const bf16*)(ws + WS_XB1), (bf16*)(ws + WS_XB0), (float*)(ws + WS_SS0), L == 0 ? nullptr : a.in[28], 1.0f};
    pg8::gemm_phase<pg8::EpiResid<false>, pg8::StaticOrder, true, true>(lds, g, S, E);
}
template <int L> __device__ __forceinline__ void ph_mix_in(const Args& a, LAS unsigned char* lds) {
    unsigned char* ws = a.ws;
    if constexpr (L == 0) {
        pg8::Gemm g{(const bf16*)(ws + WS_XB1), (const bf16*)(ws + WS_WIN), M, 2 * GW, D, 256, (size_t)256 * D * 2, 131072, 2}; pg8::StaticOrder S; S.init(M, 2 * GW, gridDim.x, blockIdx.x);
        pg8::EpiGelu E{(bf16*)(ws + WS_BIG), 2 * GW, (const float*)(ws + WS_SS1), (float*)(ws + WS_VSTAT), stage_rstd(lds, (const float*)(ws + WS_SS1), 2 * GW)};
        pg8::gemm_phase<pg8::EpiGelu, pg8::StaticOrder, true, true>(lds, g, S, E);
    } else {
        pg8::Gemm g{(const bf16*)(ws + WS_XB1), (const bf16*)(ws + WS_WQKV), M, QKVW, D, 256, (size_t)256 * D * 2, 131072, 2}; pg8::StaticOrder S; S.init(M, QKVW, gridDim.x, blockIdx.x);
        pg8::EpiQKV E{(bf16*)(ws + WS_BIG) + arena_adj(QKVW), QKVW, (const float*)(ws + WS_SS1), a.in[21], a.in[23], a.in[25], stage_rstd(lds, (const float*)(ws + WS_SS1), QKVW)};
        pg8::gemm_phase<pg8::EpiQKV, pg8::StaticOrder, true, true>(lds, g, S, E);
    }
}
template <int L> __device__ __forceinline__ void ph_ple_gate(const Args& a, LAS unsigned char* lds) {
    unsigned char* ws = a.ws;
    pg8::Gemm g{(const bf16*)(ws + WS_XB1), (const bf16*)(ws + WS_WG + (size_t)L * SZ_WG), M, D, D, 256, (size_t)256 * D * 2, 131072, 2}; pg8::StaticOrder S; S.init(M, D, gridDim.x, blockIdx.x);
    pg8::EpiPLE<(L == 1)> E{(const bf16*)(ws + WS_XB1), a.out, (bf16*)(ws + WS_XB0), (float*)(ws + WS_SS0), (const float*)(ws + WS_SS1), (const bf16*)(ws + WS_PJ), stage_rstd(lds, (const float*)(ws + WS_SS1), D)};
    pg8::gemm_phase<pg8::EpiPLE<(L == 1)>, pg8::StaticOrder, true, true>(lds, g, S, E);
}
template <int L> __device__ __forceinline__ void layer(const Args& a, LAS unsigned char* lds, const int lo, const int hi, const XcdBarrier& bar, const Team& T) {
    constexpr int P = 1 + 8 * L; unsigned char* ws = a.ws;
    if (IN(P + 0)) ph_ffn_up<0, L>(a, lds);
    SEAM_T(P + 0);
    if (IN(P + 1)) ph_ffn_down<0, L>(a, lds);
    SEAM_T(P + 1);
    if (IN(P + 2)) ph_mix_in<L>(a, lds);
    SEAM(P + 2);
    if (IN(P + 3)) {
        if constexpr (L == 0) spatial_phase(lds, (const bf16*)(ws + WS_BIG), (bf16*)(ws + WS_BIG), (const float*)(ws + WS_VSTAT), a.in[15], a.in[16], a.in[17], a.in[18]);
        else attn_phase(lds, (const bf16*)(ws + WS_BIG), (bf16*)(ws + WS_BIG) + (team_mode() ? (size_t)256 * QKVW : (size_t)M * QKVW), (const float*)(ws + WS_ROPE), a.in[26]);
    }
    SEAM(P + 3);
    if (IN(P + 4)) ph_mix_out<L>(a, lds);
    SEAM_T(P + 4);
    if (IN(P + 5)) { ph_ffn_up<1, L>(a, lds); ph_ple_proj<L>(a, lds); }
    SEAM_T(P + 5);
    if (IN(P + 6)) ph_ffn_down<1, L>(a, lds);
    SEAM_T(P + 6);
    if (IN(P + 7)) ph_ple_gate<L>(a, lds);
    SEAM_T(P + 7);
}
__global__ void __launch_bounds__(512, 2) mega_fwd(Args a) {
    extern __shared__ __attribute__((aligned(16))) unsigned char lds_raw[];
    LAS unsigned char* lds = (LAS unsigned char*)lds_raw;
    const int lo = a.lo, hi = a.hi;
    unsigned* barw = (unsigned*)(a.ws + WS_CTL);
    volatile LAS unsigned* MISC = (volatile LAS unsigned*)(lds + MISC_OFF);
    if (threadIdx.x < 16) MISC[threadIdx.x] = 0u;
    if (IN(0)) {
        if (blockIdx.x == 0) for (int i = threadIdx.x; i < 8192; i += 512) __hip_atomic_store(barw + i, 0u, __ATOMIC_RELAXED, __HIP_MEMORY_SCOPE_AGENT);
        if (threadIdx.x == 0) __hip_atomic_store(barw + 8192 + blockIdx.x, xb_xcc_id() + 1u, __ATOMIC_RELAXED, __HIP_MEMORY_SCOPE_AGENT);
        p0_prologue(a, lds);
    }
    __syncthreads();
    XcdBarrier bar; bar.bar = barw; bar.x = 0; bar.st = nullptr;
    Team T; T.on = false; T.same = false; T.pm = my_pm(); T.j = blockIdx.x >> 6; T.cnt = barw + 4096 + 64 * T.pm; T.tmo = barw;
    if (IN(0) && IN(1)) { cg::this_grid().sync(); bar = xcd_barrier_post(barw, MISC + 8);
        if (team_mode() && lo == 0 && hi == NPHASE) {
            if (threadIdx.x == 0) { const unsigned me = xb_xcc_id() + 1u; bool sm = true;
#pragma unroll
                for (int j = 0; j < 4; ++j) sm = sm && (xb_ld(barw + 8192 + (blockIdx.x & 63) + 64 * j) == me);
                MISC[12] = sm ? 1u : 0u; }
            __syncthreads();
            T.on = true; T.same = MISC[12] != 0u; } }
    layer<0>(a, lds, lo, hi, bar, T);
    layer<1>(a, lds, lo, hi, bar, T);
    if (IN(NPHASE - 1)) final_phase(a.out, (const float*)(a.ws + WS_SS0), a.in[29], T.on);
}
#undef IN
#undef SEAM
#undef SEAM_T

extern "C" void kernel_launch(void* const* d_in, const int* in_sizes, int n_in, void* d_out, int out_size, void* d_ws, size_t ws_size, hipStream_t stream) {
    static int grid = 0;
    if (grid == 0) {
        if (n_in != 30 || in_sizes[0] != M * D || out_size != M * D || ws_size < WS_END) { fprintf(stderr, "kernel_launch: unexpected shapes / workspace (n_in %d, in0 %d, out %d, ws %zu, need %zu)\n", n_in, n_in > 0 ? in_sizes[0] : -1, out_size, ws_size, (size_t)WS_END); grid = -1; return; }
        int dev = 0, cus = 0, per_cu = 0;
        if (hipGetDevice(&dev) != hipSuccess || hipDeviceGetAttribute(&cus, hipDeviceAttributeMultiprocessorCount, dev) != hipSuccess) { grid = -1; return; }
        if (hipFuncSetAttribute((const void*)mega_fwd, hipFuncAttributeMaxDynamicSharedMemorySize, LDS_BYTES) != hipSuccess) { fprintf(stderr, "kernel_launch: hipFuncSetAttribute failed\n"); grid = -1; return; }
        if (hipOccupancyMaxActiveBlocksPerMultiprocessor(&per_cu, (const void*)mega_fwd, 512, LDS_BYTES) != hipSuccess || per_cu < 1) { fprintf(stderr, "kernel_launch: occupancy query says %d blocks per CU\n", per_cu); per_cu = 1; }
        (void)hipGetLastError();
        grid = cus * (per_cu > 1 ? 1 : per_cu);
    }
    if (grid < 0) return;
    Args a{};
    for (int i = 0; i < 30; ++i) a.in[i] = (const float*)d_in[i];
    a.out = (float*)d_out; a.ws = (unsigned char*)d_ws;
    for (int j = 0; j < 8; ++j) a.invf[j] = (float)pow(500000.0, -(double)(2 * j) / 16.0);
#if MK_MULTI
    for (int ph = 0; ph < NPHASE; ++ph) { a.lo = ph; a.hi = ph + 1; hipLaunchKernelGGL(mega_fwd, dim3(grid), dim3(512), LDS_BYTES, stream, a); }
#else
    a.lo = 0; a.hi = NPHASE;
    void* args[] = {&a};
    hipError_t e = hipLaunchCooperativeKernel((const void*)mega_fwd, dim3(grid), dim3(512), args, LDS_BYTES, stream);
    if (e != hipSuccess) fprintf(stderr, "kernel_launch: cooperative launch failed: %s (grid %d)\n", hipGetErrorString(e), grid);
#endif
}
```

```cpp
#include <hip/hip_runtime.h>
#include <cstdio>
#include <cstdint>
#include <cmath>
namespace pg8 {
#define PG8_LAS __attribute__((address_space(3)))
typedef unsigned short bf16_t;
typedef short bf16x8 __attribute__((ext_vector_type(8)));
typedef float f32x4 __attribute__((ext_vector_type(4)));
typedef unsigned u32x4 __attribute__((ext_vector_type(4)));
constexpr int BM = 256, BK = 64, HALF = 128, HTB = HALF * BK * 2  , STAGE_BYTES = 8 * HTB, NXCD = 8, WGM = 8;

__host__ __device__ __forceinline__ int lds_byte(int r, int c) { const int st = (r >> 4) * 2 + (c >> 5), rr = r & 15, cc = c & 31, ob = rr * 64 + cc * 2; return st * 1024 + (ob ^ (((ob >> 9) & 1) << 5)); }
__host__ __device__ __forceinline__ void stage_rc(int b, int& R, int& C) { const int st = b / 1024, sb = b % 1024, swz = sb ^ (((sb >> 9) & 1) << 5); R = (st >> 1) * 16 + swz / 64; C = (st & 1) * 32 + (swz % 64) / 2; }
__host__ __device__ __forceinline__ int perm32(int rho) { const int n = rho >> 4, i = rho & 15; return 8 * (i >> 2) + 4 * n + (i & 3); }

struct Unit { int pm, pn; };
struct Gemm { const bf16_t* A; const bf16_t* Bt; int M, N, K, lda; size_t a_tstep; int a_blk, a_sh; };

struct StaticOrder {
    int nM, nN, nwg, G, c;
    __host__ __device__ void init(int M, int N, int G_, int c_) { nM = M / BM; nN = N / BM; nwg = nM * nN; G = G_; c = c_; }
    __host__ __device__ bool next(int i, Unit& u) const {
        const long L = (long)i * G + c; if (L >= nwg) return false;
        int wgid = (int)L; { const int q = nwg / NXCD, r = nwg % NXCD, xcd = wgid % NXCD, off = wgid / NXCD; wgid = (xcd < r ? xcd * (q + 1) : r * (q + 1) + (xcd - r) * q) + off; }
        const int nig = WGM * nN, gid = wgid / nig, fm = gid * WGM, gsz = (nM - fm) < WGM ? (nM - fm) : WGM;
        u.pm = fm + ((wgid % nig) % gsz); u.pn = (wgid % nig) / gsz; return true;
    }
    __device__ __forceinline__ void a_ready(const Unit&) const {}
    __device__ __forceinline__ void done(const Unit&) const {}
};

__device__ __forceinline__ unsigned cvt_pk_bf16(float lo, float hi) { unsigned r; asm volatile("v_cvt_pk_bf16_f32 %0, %1, %2" : "=v"(r) : "v"(lo), "v"(hi)); return r; }
typedef float f32x2 __attribute__((ext_vector_type(2)));
__device__ __forceinline__ f32x2 gelu_pk(f32x2 v) {
    const f32x2 av = __builtin_elementwise_abs(v), d = av * 0.2316418882f + 1.0f;
    f32x2 t; t.x = __builtin_amdgcn_rcpf(d.x); t.y = __builtin_amdgcn_rcpf(d.y);
    f32x2 q = t * 0.5307027145f + (-0.7265760135f); q = q * t + 0.7107068705f; q = q * t + (-0.142248368f); q = q * t + 0.127414796f; q = q * t;
    const f32x2 s = (v * v) * (-0.72134752044f);
    f32x2 e; e.x = __builtin_amdgcn_exp2f(s.x); e.y = __builtin_amdgcn_exp2f(s.y);
    const f32x2 m = v * (q * e), r = v - m;
    f32x2 o; o.x = v.x < 0.f ? m.x : r.x; o.y = v.y < 0.f ? m.y : r.y; return o;
}
constexpr int XD = 2048;
typedef unsigned u32x2 __attribute__((ext_vector_type(2)));
__device__ __forceinline__ float row_rstd(const float* ssqp, int row, int fq) {
    const f32x4* p = (const f32x4*)(ssqp + (size_t)row * 32 + fq * 8);
    const f32x4 a = p[0], b = p[1];
    float s = ((a[0] + a[1]) + (a[2] + a[3])) + ((b[0] + b[1]) + (b[2] + b[3]));
    s += __shfl_xor(s, 16); s += __shfl_xor(s, 32);
    return __builtin_amdgcn_rsqf(s * (1.0f / 2048.0f) + 1e-6f);
}
__device__ __forceinline__ float tile_rstd(const PG8_LAS float* rsl, const float* ssqp, int row, int fq) { return rsl ? rsl[row & (BM - 1)] : row_rstd(ssqp, row, fq); }
__device__ __forceinline__ float sigmoid_f(float z) { return __builtin_amdgcn_rcpf(1.0f + __builtin_amdgcn_exp2f(z * -1.4426950408889634f)); }
__device__ __forceinline__ u32x4 pack8(const f32x4& v0, const f32x4& v1) { u32x4 w; w.x = cvt_pk_bf16(v0[0], v0[1]); w.y = cvt_pk_bf16(v0[2], v0[3]); w.z = cvt_pk_bf16(v1[0], v1[1]); w.w = cvt_pk_bf16(v1[2], v1[3]); return w; }
__device__ __forceinline__ float bf_lo(unsigned w) { return __uint_as_float(w << 16); }
__device__ __forceinline__ float bf_hi(unsigned w) { return __uint_as_float(w & 0xffff0000u); }

struct EpiSwiGLU {
    static constexpr bool PERM = true, AFTER_DRAIN = false;
    bf16_t* H; size_t pstride; const float* ssqp; const PG8_LAS float* rsl;
    __device__ __forceinline__ void operator()(const f32x4 (&acc)[2][2][4][2], const Unit& u, int wr, int wc, int fr, int fq) const {
        const int row0 = u.pm * BM + wr * 64 + fr, col0 = u.pn * HALF + wc * 32 + 8 * fq;
        float rs[2][4];
#pragma unroll
        for (int ai = 0; ai < 2; ++ai) {
#pragma unroll
            for (int m = 0; m < 4; ++m) rs[ai][m] = tile_rstd(rsl, ssqp, row0 + ai * HALF + m * 16, fq);
            asm volatile("" ::: "memory"); }
        asm volatile("" ::: "memory");
#pragma unroll
        for (int ai = 0; ai < 2; ++ai)
#pragma unroll
            for (int m = 0; m < 4; ++m) { const int row = row0 + ai * HALF + m * 16; const float r = rs[ai][m];
                f32x4 h[2];
#pragma unroll
                for (int n = 0; n < 2; ++n) { const f32x4 a = acc[ai][0][m][n] * r, b = acc[ai][1][m][n] * r;
#pragma unroll
                    for (int e = 0; e < 4; ++e) h[n][e] = a[e] * b[e] * sigmoid_f(a[e]); }
                *(u32x4*)(H + (size_t)u.pm * pstride + (size_t)u.pn * 32768 + (size_t)(wr * 64 + fr + ai * HALF + m * 16) * HALF + wc * 32 + 8 * fq) = pack8(h[0], h[1]); }
    }
};
__device__ __forceinline__ void unpack8(const u32x4& w, f32x4& v0, f32x4& v1) { v0 = (f32x4){bf_lo(w.x), bf_hi(w.x), bf_lo(w.y), bf_hi(w.y)}; v1 = (f32x4){bf_lo(w.z), bf_hi(w.z), bf_lo(w.w), bf_hi(w.w)}; }
template <bool F32IN> struct EpiResid {
    static constexpr bool PERM = true, AFTER_DRAIN = false;
    static constexpr int NB = F32IN ? 2 : 8;
    const float* xin_f; const bf16_t* xin_b; bf16_t* xb; float* ssq_out; const float* bias; float alpha;
    __device__ __forceinline__ void operator()(const f32x4 (&acc)[2][2][4][2], const Unit& u, int wr, int wc, int fr, int fq) const {
        const int row0 = u.pm * BM + wr * 64 + fr, col0 = u.pn * BM + wc * 32 + 8 * fq;
        const size_t tb = (size_t)(u.pm * 8 + u.pn) * 65536 + wc * 32 + 8 * fq; const int rit0 = wr * 64 + fr;
        f32x4 bv[2][2];
#pragma unroll
        for (int bj = 0; bj < 2; ++bj)
#pragma unroll
            for (int n = 0; n < 2; ++n) bv[bj][n] = bias ? *(const f32x4*)(bias + col0 + bj * HALF + 4 * n) : (f32x4){0.f, 0.f, 0.f, 0.f};
#pragma unroll
        for (int bt = 0; bt < 8 / NB; ++bt) {
            f32x4 xv[F32IN ? NB : 1][2][2]; u32x4 xw[F32IN ? 1 : NB][2];
#pragma unroll
            for (int mm = 0; mm < NB; ++mm)
#pragma unroll
                for (int bj = 0; bj < 2; ++bj) { const int rg = NB * bt + mm;
                    if constexpr (F32IN) { const size_t off = (size_t)(row0 + (rg >> 2) * HALF + (rg & 3) * 16) * XD + col0 + bj * HALF; xv[mm][bj][0] = *(const f32x4*)(xin_f + off); xv[mm][bj][1] = *(const f32x4*)(xin_f + off + 4); }
                    else xw[mm][bj] = *(const u32x4*)(xin_b + tb + (size_t)(rit0 + (rg >> 2) * HALF + (rg & 3) * 16) * BM + bj * HALF); }
            asm volatile("" ::: "memory");
#pragma unroll
            for (int mm = 0; mm < NB; ++mm) { const int rg = NB * bt + mm, ai = rg >> 2, m = rg & 3; const int row = row0 + ai * HALF + m * 16; float ss = 0.f;
#pragma unroll
                for (int bj = 0; bj < 2; ++bj) {
                    f32x4 x0, x1; if constexpr (F32IN) { x0 = xv[mm][bj][0]; x1 = xv[mm][bj][1]; } else unpack8(xw[mm][bj], x0, x1);
                    const f32x4 v0 = x0 + acc[ai][bj][m][0] * alpha + bv[bj][0], v1 = x1 + acc[ai][bj][m][1] * alpha + bv[bj][1];
                    *(u32x4*)(xb + tb + (size_t)(rit0 + ai * HALF + m * 16) * BM + bj * HALF) = pack8(v0, v1);
                    ss += (v0[0] * v0[0] + v0[1] * v0[1]) + (v0[2] * v0[2] + v0[3] * v0[3]) + (v1[0] * v1[0] + v1[1] * v1[1]) + (v1[2] * v1[2] + v1[3] * v1[3]); }
                ss += __shfl_xor(ss, 16); ss += __shfl_xor(ss, 32);
                if (fq == 0) ssq_out[(size_t)row * 32 + u.pn * 4 + wc] = ss; }
            asm volatile("" ::: "memory");
        }
    }
};
struct EpiGelu {
    static constexpr bool PERM = true, AFTER_DRAIN = false;
    bf16_t* Z; int ldz; const float* ssqp; float* vstat; const PG8_LAS float* rsl;
    __device__ __forceinline__ void operator()(const f32x4 (&acc)[2][2][4][2], const Unit& u, int wr, int wc, int fr, int fq) const {
        const int row0 = u.pm * BM + wr * 64 + fr, col0 = u.pn * BM + wc * 32 + 8 * fq;
        float rsv[2][4];
#pragma unroll
        for (int ai = 0; ai < 2; ++ai) {
#pragma unroll
            for (int m = 0; m < 4; ++m) rsv[ai][m] = tile_rstd(rsl, ssqp, row0 + ai * HALF + m * 16, fq);
            asm volatile("" ::: "memory"); }
        asm volatile("" ::: "memory");
#pragma unroll
        for (int ai = 0; ai < 2; ++ai)
#pragma unroll
            for (int m = 0; m < 4; ++m) { const int row = row0 + ai * HALF + m * 16; const float rs = rsv[ai][m]; float s1 = 0.f, s2 = 0.f;
#pragma unroll
                for (int bj = 0; bj < 2; ++bj) { f32x4 v0 = acc[ai][bj][m][0] * rs, v1 = acc[ai][bj][m][1] * rs;
                    const f32x2 a = gelu_pk((f32x2){v0[0], v0[1]}), b = gelu_pk((f32x2){v0[2], v0[3]}), c = gelu_pk((f32x2){v1[0], v1[1]}), d = gelu_pk((f32x2){v1[2], v1[3]});
                    v0 = (f32x4){a.x, a.y, b.x, b.y}; v1 = (f32x4){c.x, c.y, d.x, d.y};
                    *(u32x4*)(Z + (size_t)u.pm * 2097152 + (size_t)u.pn * 65536 + (size_t)(wr * 64 + fr + ai * HALF + m * 16) * BM + wc * 32 + 8 * fq + bj * HALF) = pack8(v0, v1);
                    s1 += ((v0[0] + v0[1]) + (v0[2] + v0[3])) + ((v1[0] + v1[1]) + (v1[2] + v1[3]));
                    s2 += (v0[0] * v0[0] + v0[1] * v0[1]) + (v0[2] * v0[2] + v0[3] * v0[3]) + (v1[0] * v1[0] + v1[1] * v1[1]) + (v1[2] * v1[2] + v1[3] * v1[3]); }
                if (u.pn >= 16) { s1 += __shfl_xor(s1, 16); s1 += __shfl_xor(s1, 32); s2 += __shfl_xor(s2, 16); s2 += __shfl_xor(s2, 32);
                    if (fq == 0) *(f32x2*)(vstat + ((size_t)row * 64 + (u.pn - 16) * 4 + wc) * 2) = (f32x2){s1, s2}; } }
    }
};
struct EpiQKV {
    static constexpr bool PERM = true, AFTER_DRAIN = false;
    bf16_t* O; int ldo; const float* ssqp; const float* bq; const float* bk; const float* bv; const PG8_LAS float* rsl;
    __device__ __forceinline__ void operator()(const f32x4 (&acc)[2][2][4][2], const Unit& u, int wr, int wc, int fr, int fq) const {
        const int row0 = u.pm * BM + wr * 64 + fr, cin = wc * 32 + 8 * fq, col0 = u.pn * BM + cin;
        const float* bp = bq ? (u.pn < 8 ? bq + u.pn * BM : (u.pn == 8 ? bk : bv)) + cin : nullptr;
        f32x4 bvv[2][2];
#pragma unroll
        for (int bj = 0; bj < 2; ++bj)
#pragma unroll
            for (int n = 0; n < 2; ++n) bvv[bj][n] = bp ? *(const f32x4*)(bp + bj * HALF + 4 * n) : (f32x4){0.f, 0.f, 0.f, 0.f};
#pragma unroll
        for (int ai = 0; ai < 2; ++ai) {
            float rsv[4];
#pragma unroll
            for (int m = 0; m < 4; ++m) rsv[m] = ssqp ? tile_rstd(rsl, ssqp, row0 + ai * HALF + m * 16, fq) : 1.0f;
            asm volatile("" ::: "memory");
#pragma unroll
            for (int m = 0; m < 4; ++m) { const int row = row0 + ai * HALF + m * 16; const float rs = rsv[m];
#pragma unroll
                for (int bj = 0; bj < 2; ++bj) *(u32x4*)(O + (size_t)row * ldo + col0 + bj * HALF) = pack8(acc[ai][bj][m][0] * rs + bvv[bj][0], acc[ai][bj][m][1] * rs + bvv[bj][1]); }
            asm volatile("" ::: "memory");
        }
    }
};
template <bool LAST> struct EpiPLE {
    static constexpr bool PERM = true, AFTER_DRAIN = false; static constexpr int MB = 4;
    const bf16_t* xin_b; float* xout_f; bf16_t* xb; float* ssq_out; const float* ssqp; const bf16_t* pj; const PG8_LAS float* rsl;
    __device__ __forceinline__ void operator()(const f32x4 (&acc)[2][2][4][2], const Unit& u, int wr, int wc, int fr, int fq) const {
        const int row0 = u.pm * BM + wr * 64 + fr, col0 = u.pn * BM + wc * 32 + 8 * fq;
        const size_t tb = (size_t)(u.pm * 8 + u.pn) * 65536 + wc * 32 + 8 * fq; const int rit0 = wr * 64 + fr;
#pragma unroll
        for (int ai = 0; ai < 2; ++ai)
#pragma unroll
            for (int mh = 0; mh < 4 / MB; ++mh) {
                float rsv[MB];
#pragma unroll
                for (int mm = 0; mm < MB; ++mm) rsv[mm] = tile_rstd(rsl, ssqp, row0 + ai * HALF + (MB * mh + mm) * 16, fq);
                u32x4 xw[MB][2], pv[MB][2];
#pragma unroll
                for (int mm = 0; mm < MB; ++mm)
#pragma unroll
                    for (int bj = 0; bj < 2; ++bj) { const size_t off = (size_t)(row0 + ai * HALF + (MB * mh + mm) * 16) * XD + col0 + bj * HALF; xw[mm][bj] = *(const u32x4*)(xin_b + tb + (size_t)(rit0 + ai * HALF + (MB * mh + mm) * 16) * BM + bj * HALF); pv[mm][bj] = *(const u32x4*)(pj + off); }
                asm volatile("" ::: "memory");
#pragma unroll
                for (int mm = 0; mm < MB; ++mm) { const int m = MB * mh + mm; const int row = row0 + ai * HALF + m * 16; const size_t off = (size_t)row * XD + col0; const float rs = rsv[mm]; float ss = 0.f;
#pragma unroll
                    for (int bj = 0; bj < 2; ++bj) { f32x4 x0, x1, p0, p1; unpack8(xw[mm][bj], x0, x1); unpack8(pv[mm][bj], p0, p1);
                        f32x4 v0, v1;
#pragma unroll
                        for (int e = 0; e < 4; ++e) { v0[e] = x0[e] + sigmoid_f(acc[ai][bj][m][0][e] * rs) * p0[e]; v1[e] = x1[e] + sigmoid_f(acc[ai][bj][m][1][e] * rs) * p1[e]; }
                        if constexpr (LAST) { *(f32x4*)(xout_f + off + bj * HALF) = v0; *(f32x4*)(xout_f + off + bj * HALF + 4) = v1; }
                        else *(u32x4*)(xb + tb + (size_t)(rit0 + ai * HALF + m * 16) * BM + bj * HALF) = pack8(v0, v1);
                        ss += (v0[0] * v0[0] + v0[1] * v0[1]) + (v0[2] * v0[2] + v0[3] * v0[3]) + (v1[0] * v1[0] + v1[1] * v1[1]) + (v1[2] * v1[2] + v1[3] * v1[3]); }
                    ss += __shfl_xor(ss, 16); ss += __shfl_xor(ss, 32);
                    if (fq == 0) ssq_out[(size_t)row * 32 + u.pn * 4 + wc] = ss; }
                asm volatile("" ::: "memory");
            }
    }
};

template <class Epi, class Sched, bool ALIGN_EPI = false, bool SP2 = false>
__device__ __forceinline__ void gemm_phase(PG8_LAS unsigned char* lds, const Gemm g, const Sched& S, const Epi& E) {
    const int tid = threadIdx.x, wid = __builtin_amdgcn_readfirstlane(tid >> 6), lane = tid & 63, wr = wid >> 2, wc = wid & 3, fr = lane & 15, fq = lane >> 4;
    const int K = g.K, nt = K / BK;
    unsigned voffA[2], voffB[2];
#pragma unroll
    for (int i = 0; i < 2; ++i) { int R, C; stage_rc(tid * 16 + i * 8192, R, C); const int Rb = Epi::PERM ? ((R & ~31) + perm32(R & 31)) : R;
        voffA[i] = (unsigned)(R * g.lda + C) * 2u; voffB[i] = (unsigned)(Rb * K + C) * 2u; }
    const size_t kstep = (size_t)(BK * 2);
    const size_t hstepA = (size_t)HALF * g.lda * 2, hstepB = (size_t)HALF * K * 2;
    const size_t tstepA = g.a_tstep ? g.a_tstep : 2 * hstepA, tstepB = 2 * hstepB;
    const unsigned ldsw = (unsigned)wid * 1024u;
    const int aoff = lds_byte(wr * 64 + fr, fq * 8), boff = lds_byte(wc * 32 + fr, fq * 8);
#define PG8_SA(b, h) (((b) * 2 + (h)) * HTB)
#define PG8_SB(b, h) ((4 + (b) * 2 + (h)) * HTB)
#define PG8_STAGE(bufoff, gbase, voff) do { const unsigned long long gb_ = (unsigned long long)(gbase); _Pragma("unroll") for (int _i = 0; _i < 2; ++_i) { unsigned keep_; \
        asm volatile("s_mov_b32 m0, %2\n\ts_nop 0\n\tglobal_load_lds_dwordx4 %0, %1" : : "v"((voff)[_i]), "s"(gb_), "s"((unsigned)(size_t)(lds + (bufoff) + ldsw + _i * 8192)) : "memory", "m0"); (void)keep_; } } while (0)
#define PG8_LDA(dst, b, h) do { _Pragma("unroll") for (int m = 0; m < 4; ++m) _Pragma("unroll") for (int k = 0; k < 2; ++k) dst[m][k] = *(const PG8_LAS bf16x8*)(lds + PG8_SA(b, h) + aoff + m * 2048 + k * 1024); } while (0)
#define PG8_LDB(dst, b, h) do { _Pragma("unroll") for (int n = 0; n < 2; ++n) _Pragma("unroll") for (int k = 0; k < 2; ++k) dst[n][k] = *(const PG8_LAS bf16x8*)(lds + PG8_SB(b, h) + boff + n * 2048 + k * 1024); } while (0)
#define PG8_MMA(ai, bj, At, Bt) do { __builtin_amdgcn_s_setprio(1); _Pragma("unroll") for (int m = 0; m < 4; ++m) _Pragma("unroll") for (int n = 0; n < 2; ++n) _Pragma("unroll") for (int k = 0; k < 2; ++k) \
        acc[ai][bj][m][n] = __builtin_amdgcn_mfma_f32_16x16x32_bf16(Bt[n][k], At[m][k], acc[ai][bj][m][n], 0, 0, 0); __builtin_amdgcn_s_setprio(0); } while (0)
#define PG8_WAIT_V(n) asm volatile("s_waitcnt vmcnt(" #n ")" ::: "memory")
#define PG8_WAIT_L(n) asm volatile("s_waitcnt lgkmcnt(" #n ")" ::: "memory")
#define PG8_BAR __builtin_amdgcn_s_barrier()
#define PG8_SCHED __builtin_amdgcn_sched_barrier(0)
    Unit cur, nxt; int ui = 0;
    if (!S.next(0, cur)) return;
    f32x4 acc[2][2][4][2];
#pragma unroll
    for (int a = 0; a < 2; ++a)
#pragma unroll
        for (int b = 0; b < 2; ++b)
#pragma unroll
            for (int m = 0; m < 4; ++m)
#pragma unroll
                for (int n = 0; n < 2; ++n) acc[a][b][m][n] = (f32x4){0.f, 0.f, 0.f, 0.f};
    bf16x8 At[4][2], B0[2][2], B1[2][2];
    const char* cA = (const char*)g.A + (size_t)cur.pm * tstepA; const char* cB = (const char*)g.Bt + (size_t)cur.pn * tstepB;
    S.a_ready(cur);
    if constexpr (SP2) {
        PG8_STAGE(PG8_SB(0, 0), cB, voffB); PG8_STAGE(PG8_SB(0, 1), cB + hstepB, voffB); PG8_STAGE(PG8_SA(0, 0), cA, voffA); PG8_STAGE(PG8_SA(0, 1), cA + hstepA, voffA);
        if (wr == 1) PG8_BAR;
        PG8_WAIT_V(2); PG8_BAR;
        PG8_STAGE(PG8_SB(1, 0), cB + kstep, voffB); PG8_STAGE(PG8_SA(1, 0), cA + kstep, voffA); PG8_STAGE(PG8_SB(1, 1), cB + hstepB + kstep, voffB);
        PG8_WAIT_V(6); PG8_BAR;
    } else {
        PG8_STAGE(PG8_SB(0, 0), cB, voffB); PG8_STAGE(PG8_SA(0, 0), cA, voffA); PG8_STAGE(PG8_SB(0, 1), cB + hstepB, voffB); PG8_STAGE(PG8_SA(0, 1), cA + hstepA, voffA);
        if (wr == 1) PG8_BAR;
        PG8_WAIT_V(4); PG8_BAR;
        PG8_STAGE(PG8_SB(1, 0), cB + kstep, voffB); PG8_STAGE(PG8_SA(1, 0), cA + kstep, voffA); PG8_STAGE(PG8_SB(1, 1), cB + hstepB + kstep, voffB);
        PG8_WAIT_V(6); PG8_BAR;
    }
    for (;;) {
        const bool has_next = S.next(ui + 1, nxt);
        const char* nA = has_next ? (const char*)g.A + (size_t)nxt.pm * tstepA : cA; const char* nB = has_next ? (const char*)g.Bt + (size_t)nxt.pn * tstepB : cB;
        for (int t = 0; t < nt; t += 2) {
            const bool last = (t == nt - 2);
#define PG8_KOFFA(tt) (g.a_blk ? (size_t)((tt) >> g.a_sh) * (size_t)g.a_blk + (size_t)((tt) & ((1 << g.a_sh) - 1)) * kstep : (size_t)(tt) * kstep)
            const char* a1 = cA + PG8_KOFFA(t + 1);
            const char* a2 = last ? nA : cA + PG8_KOFFA(t + 2); const char* b2 = last ? nB : cB + (size_t)(t + 2) * kstep;
            const char* a3 = last ? nA + kstep : cA + PG8_KOFFA(t + 3); const char* b3 = b2 + kstep;
#undef PG8_KOFFA
            if (last && has_next) S.a_ready(nxt);
            if constexpr (SP2) {
            PG8_LDB(B0, 0, 0); PG8_LDB(B1, 0, 1); PG8_SCHED; PG8_LDA(At, 0, 0); PG8_STAGE(PG8_SA(1, 1), a1 + hstepA, voffA);
            PG8_WAIT_V(8); PG8_WAIT_L(0); PG8_BAR; PG8_MMA(0, 0, At, B0); PG8_MMA(0, 1, At, B1); PG8_BAR; PG8_SCHED;
            PG8_LDA(At, 0, 1); PG8_STAGE(PG8_SB(0, 0), b2, voffB); PG8_STAGE(PG8_SB(0, 1), b2 + hstepB, voffB); PG8_STAGE(PG8_SA(0, 0), a2, voffA);
            PG8_WAIT_V(8); PG8_WAIT_L(0); PG8_BAR; PG8_MMA(1, 0, At, B0); PG8_MMA(1, 1, At, B1); PG8_BAR; PG8_SCHED;
            PG8_LDB(B0, 1, 0); PG8_LDB(B1, 1, 1); PG8_SCHED; PG8_LDA(At, 1, 0); PG8_STAGE(PG8_SA(0, 1), a2 + hstepA, voffA);
            PG8_WAIT_V(8); PG8_WAIT_L(0); PG8_BAR; PG8_MMA(0, 0, At, B0); PG8_MMA(0, 1, At, B1); PG8_BAR; PG8_SCHED;
            PG8_LDA(At, 1, 1); PG8_STAGE(PG8_SB(1, 0), b3, voffB); PG8_STAGE(PG8_SB(1, 1), b3 + hstepB, voffB); PG8_STAGE(PG8_SA(1, 0), a3, voffA);
            PG8_WAIT_V(8); PG8_WAIT_L(0); PG8_BAR; PG8_MMA(1, 0, At, B0); PG8_MMA(1, 1, At, B1); PG8_BAR; PG8_SCHED;
            } else {
            PG8_LDB(B0, 0, 0); PG8_SCHED; PG8_LDA(At, 0, 0); PG8_STAGE(PG8_SA(1, 1), a1 + hstepA, voffA);
            PG8_WAIT_L(8); PG8_BAR; PG8_WAIT_L(0); PG8_MMA(0, 0, At, B0); PG8_BAR; PG8_SCHED;
            PG8_LDB(B1, 0, 1); PG8_STAGE(PG8_SB(0, 0), b2, voffB);
            PG8_BAR; PG8_WAIT_L(0); PG8_MMA(0, 1, At, B1); PG8_BAR;
            PG8_LDA(At, 0, 1); PG8_STAGE(PG8_SA(0, 0), a2, voffA);
            PG8_BAR; PG8_WAIT_L(0); PG8_MMA(1, 0, At, B0); PG8_BAR; PG8_SCHED;
            PG8_STAGE(PG8_SB(0, 1), b2 + hstepB, voffB);
            PG8_WAIT_V(6); PG8_BAR; PG8_MMA(1, 1, At, B1); PG8_BAR;
            PG8_LDB(B0, 1, 0); PG8_SCHED; PG8_LDA(At, 1, 0); PG8_STAGE(PG8_SA(0, 1), a2 + hstepA, voffA);
            PG8_WAIT_L(8); PG8_BAR; PG8_WAIT_L(0); PG8_MMA(0, 0, At, B0); PG8_BAR; PG8_SCHED;
            PG8_LDB(B1, 1, 1); PG8_STAGE(PG8_SB(1, 0), b3, voffB);
            PG8_BAR; PG8_WAIT_L(0); PG8_MMA(0, 1, At, B1); PG8_BAR;
            PG8_LDA(At, 1, 1); PG8_STAGE(PG8_SA(1, 0), a3, voffA);
            PG8_BAR; PG8_WAIT_L(0); PG8_MMA(1, 0, At, B0); PG8_BAR; PG8_SCHED;
            PG8_STAGE(PG8_SB(1, 1), b3 + hstepB, voffB);
            PG8_WAIT_V(6); PG8_BAR; PG8_MMA(1, 1, At, B1); PG8_BAR;
            }
        }
        if constexpr (ALIGN_EPI) { if (wr == 0) PG8_BAR; }
        if constexpr (!Epi::AFTER_DRAIN) { E(acc, cur, wr, wc, fr, fq); S.done(cur); }
        if (!has_next) break;
#pragma unroll
        for (int a = 0; a < 2; ++a)
#pragma unroll
            for (int b = 0; b < 2; ++b)
#pragma unroll
                for (int m = 0; m < 4; ++m)
#pragma unroll
                    for (int n = 0; n < 2; ++n) acc[a][b][m][n] = (f32x4){0.f, 0.f, 0.f, 0.f};
        cur = nxt; cA = nA; cB = nB; ++ui;
        if constexpr (ALIGN_EPI) { if (wr == 1) PG8_BAR; }
    }
    PG8_WAIT_V(0);
    if constexpr (!ALIGN_EPI) { if (wr == 0) PG8_BAR; }
    PG8_BAR;
    if constexpr (Epi::AFTER_DRAIN) { E.fused(acc, cur, wr, wc, fr, fq, lds, wid, lane); S.done(cur); }
#undef PG8_SA
#undef PG8_SB
#undef PG8_STAGE
#undef PG8_LDA
#undef PG8_LDB
#undef PG8_MMA
#undef PG8_WAIT_V
#undef PG8_WAIT_L
#undef PG8_BAR
#undef PG8_SCHED
}
}
#include <hip/hip_cooperative_groups.h>
namespace cg = cooperative_groups;
#ifndef MK_MULTI
#define MK_MULTI 0
#endif
#define LAS __attribute__((address_space(3)))
typedef unsigned short bf16;
typedef float f32x4 __attribute__((ext_vector_type(4)));
typedef float f32x2 __attribute__((ext_vector_type(2)));
typedef unsigned u32x4 __attribute__((ext_vector_type(4)));
typedef unsigned u32x2 __attribute__((ext_vector_type(2)));
typedef short bf16x8 __attribute__((ext_vector_type(8)));
typedef short s16x4 __attribute__((ext_vector_type(4)));

constexpr int BATCH = 4, SEQ = 4096, M = BATCH * SEQ, D = 2048, FF = 5632, PLE = 256, GW = 4096, NQH = 32, NKV = 4, HD = 64, QKVW = 2560;
constexpr int NPHASE = 18;
constexpr size_t MiB = 1u << 20;
constexpr size_t WS_ROPE = 1 * MiB, WS_SS0 = 2 * MiB, WS_SS1 = 4 * MiB, WS_VSTAT = 6 * MiB, WS_PB = 16 * MiB, WS_XB0 = 32 * MiB, WS_XB1 = 96 * MiB, WS_PJ = 160 * MiB, WS_BIG = 224 * MiB;
constexpr size_t WS_W13 = 480 * MiB, SZ_W13 = (size_t)2 * FF * D * 2;
constexpr size_t WS_W2 = WS_W13 + 4 * SZ_W13, SZ_W2 = (size_t)D * FF * 2;
constexpr size_t WS_WG = WS_W2 + 4 * SZ_W2, SZ_WG = (size_t)D * D * 2;
constexpr size_t WS_WP = WS_WG + 2 * SZ_WG, SZ_WP = (size_t)D * PLE * 2;
constexpr size_t WS_WIN = WS_WP + 2 * SZ_WP, WS_WOUT = WS_WIN + (size_t)2 * GW * D * 2, WS_WQKV = WS_WOUT + (size_t)D * GW * 2, WS_WO = WS_WQKV + (size_t)QKVW * D * 2, WS_END = WS_WO + (size_t)D * D * 2;
constexpr int LDS_BYTES = 135168;
constexpr int MISC_OFF = 131072;
constexpr size_t WS_CTL = 0;

__device__ __forceinline__ unsigned f2bf(float f) { unsigned u = __builtin_bit_cast(unsigned, f); return (u + 0x7fffu + ((u >> 16) & 1u)) >> 16; }
__device__ __forceinline__ unsigned pk2(float lo, float hi) { return f2bf(lo) | (f2bf(hi) << 16); }
__device__ __forceinline__ float bflo(unsigned w) { return __uint_as_float(w << 16); }
__device__ __forceinline__ float bfhi(unsigned w) { return __uint_as_float(w & 0xffff0000u); }
__device__ __forceinline__ float wave_sum(float v) {
#pragma unroll
    for (int o = 1; o < 64; o <<= 1) v += __shfl_xor(v, o);
    return v;
}
#define LDS_WAIT() asm volatile("s_waitcnt lgkmcnt(0)" ::: "memory")

struct Args { const float* in[30]; float* out; unsigned char* ws; float invf[8]; int lo, hi; };

struct CvDesc { const float* src; bf16* dst; const float* gain; int K, N, mode, off, r; };
__device__ __forceinline__ void cv_load(const CvDesc& d, int lane, f32x4 (&v)[16], f32x4& g0, f32x4& g1) {
    const int nblk = d.N / 64, kb = d.r / nblk, nb = d.r % nblk, k0 = 64 * kb, n0 = 64 * nb;
    const int lk = lane >> 4, n4 = (lane & 15) * 4, c = lane & 7;
#pragma unroll
    for (int j = 0; j < 16; ++j) v[j] = __builtin_nontemporal_load((const f32x4*)(d.src + (size_t)(k0 + 4 * j + lk) * d.N + n0 + n4));
    g0 = (f32x4){1.f, 1.f, 1.f, 1.f}; g1 = g0;
    if (d.gain) { g0 = *(const f32x4*)(d.gain + k0 + 8 * c); g1 = *(const f32x4*)(d.gain + k0 + 8 * c + 4); }
}
__device__ __forceinline__ void cv_process(const CvDesc& d, int lane, const f32x4 (&v)[16], const f32x4& g0, const f32x4& g1, LAS float* scr) {
    const int nblk = d.N / 64, kb = d.r / nblk, nb = d.r % nblk, k0 = 64 * kb, n0 = 64 * nb;
    const int lk = lane >> 4, n4 = (lane & 15) * 4, c = lane & 7;
#pragma unroll
    for (int j = 0; j < 16; ++j) { const int k = 4 * j + lk; *(LAS f32x4*)(scr + k * 64 + (n4 ^ (8 * ((k >> 3) & 7)))) = v[j]; }
    LDS_WAIT(); asm volatile("" ::: "memory");
#pragma unroll
    for (int j = 0; j < 8; ++j) { const int n = (lane >> 3) + 8 * j; const LAS float* s = scr + (8 * c) * 64 + (n ^ (8 * c));
        u32x4 o; o.x = pk2(s[0 * 64] * g0[0], s[1 * 64] * g0[1]); o.y = pk2(s[2 * 64] * g0[2], s[3 * 64] * g0[3]); o.z = pk2(s[4 * 64] * g1[0], s[5 * 64] * g1[1]); o.w = pk2(s[6 * 64] * g1[2], s[7 * 64] * g1[3]);
        const int ng = n0 + n, drow = d.mode ? (((ng >> 7) << 8) + (ng & 127) + d.off) : (d.off + ng);
        *(u32x4*)(d.dst + (size_t)drow * d.K + k0 + 8 * c) = o; }
    LDS_WAIT(); asm volatile("" ::: "memory");
}
constexpr int CV_UP = (D / 64) * (FF / 64), CV_DN = (FF / 64) * (D / 64), CV_DD = (D / 64) * (D / 64), CV_PJ = (PLE / 64) * (D / 64), CV_IN = (D / 64) * (2 * GW / 64), CV_OUT = (GW / 64) * (D / 64), CV_KV = (D / 64) * (256 / 64);
constexpr int CV_LAYER = 4 * CV_UP + 2 * CV_DN + CV_DD + CV_PJ;
constexpr int CV_EARLY = CV_LAYER + 2 * CV_UP + CV_DN + CV_IN + CV_OUT + CV_DD + 2 * CV_KV;
constexpr int CV_ALL = 2 * CV_LAYER + CV_IN + CV_OUT + 2 * CV_DD + 2 * CV_KV;
__device__ __forceinline__ CvDesc cv_decode(const Args& a, int it) {
    unsigned char* ws = a.ws;
    int r = it; CvDesc d; d.src = nullptr; d.dst = nullptr; d.gain = nullptr; d.K = 64; d.N = 64; d.mode = 0; d.off = 0; d.r = 0; bool hit = false;
#define JOB(CNT, SRC, KK, NN, DST, GAIN, MODE, OFF) if (!hit) { if (r < (CNT)) { d.src = (SRC); d.K = (KK); d.N = (NN); d.dst = (bf16*)(DST); d.gain = (GAIN); d.mode = (MODE); d.off = (OFF); d.r = r; hit = true; } else r -= (CNT); }
#define FFN_JOBS(F, L, IW1, IW3, IW2, INORM) \
    JOB(CV_UP, a.in[IW1] + (size_t)(L) * D * FF, D, FF, ws + WS_W13 + (size_t)((F) * 2 + (L)) * SZ_W13, a.in[INORM] + (L) * D, 1, 0) \
    JOB(CV_UP, a.in[IW3] + (size_t)(L) * D * FF, D, FF, ws + WS_W13 + (size_t)((F) * 2 + (L)) * SZ_W13, a.in[INORM] + (L) * D, 1, 128) \
    JOB(CV_DN, a.in[IW2] + (size_t)(L) * D * FF, FF, D, ws + WS_W2 + (size_t)((F) * 2 + (L)) * SZ_W2, nullptr, 0, 0)
#define PLE_JOBS(L) \
    JOB(CV_DD, a.in[12] + (size_t)(L) * D * D, D, D, ws + WS_WG + (size_t)(L) * SZ_WG, a.in[11] + (L) * D, 0, 0) \
    JOB(CV_PJ, a.in[13] + (size_t)(L) * PLE * D, PLE, D, ws + WS_WP + (size_t)(L) * SZ_WP, nullptr, 0, 0)
    FFN_JOBS(0, 0, 3, 4, 5, 2) FFN_JOBS(1, 0, 8, 9, 10, 7) PLE_JOBS(0)
    FFN_JOBS(0, 1, 3, 4, 5, 2)
    JOB(CV_IN, a.in[14], D, 2 * GW, ws + WS_WIN, a.in[6], 0, 0)
    JOB(CV_OUT, a.in[19], GW, D, ws + WS_WOUT, nullptr, 0, 0)
    JOB(CV_DD, a.in[20], D, D, ws + WS_WQKV, a.in[6] + D, 0, 0)
    JOB(CV_KV, a.in[22], D, 256, ws + WS_WQKV, a.in[6] + D, 0, 2048)
    JOB(CV_KV, a.in[24], D, 256, ws + WS_WQKV, a.in[6] + D, 0, 2304)
    FFN_JOBS(1, 1, 8, 9, 10, 7) PLE_JOBS(1)
    JOB(CV_DD, a.in[27], D, D, ws + WS_WO, nullptr, 0, 0)
#undef PLE_JOBS
#undef FFN_JOBS
#undef JOB
    return d;
}
__device__ __forceinline__ void convert_items(const Args& a, LAS unsigned char* lds, int first, int last, int worker, int nworkers) {
    const int tid = threadIdx.x, lane = tid & 63, wave = tid >> 6;
    LAS float* scr = (LAS float*)(lds + wave * 16384);
    int it = first + worker; if (it >= last) return;
    CvDesc d0 = cv_decode(a, it), d1 = d0; f32x4 va[16], vb[16], ga0, ga1, gb0, gb1;
    cv_load(d0, lane, va, ga0, ga1);
    for (;;) {
        const int it1 = it + nworkers; const bool h1 = it1 < last;
        if (h1) { d1 = cv_decode(a, it1); cv_load(d1, lane, vb, gb0, gb1); }
        cv_process(d0, lane, va, ga0, ga1, scr);
        if (!h1) break;
        const int it2 = it1 + nworkers; const bool h2 = it2 < last;
        if (h2) { d0 = cv_decode(a, it2); cv_load(d0, lane, va, ga0, ga1); }
        cv_process(d1, lane, vb, gb0, gb1, scr);
        if (!h2) break;
        it = it2;
    }
}
__device__ __forceinline__ void p0_prologue(const Args& a, LAS unsigned char* lds) {
    const int tid = threadIdx.x, lane = tid & 63, wave = tid >> 6, G = gridDim.x;
    const int gw = blockIdx.x * 8 + wave, NGW = G * 8;
    unsigned char* ws = a.ws;
    convert_items(a, lds, 0, CV_ALL, gw, NGW);
    { const float* x = a.in[0]; bf16* xb = (bf16*)(ws + WS_XB0); float* ss0 = (float*)(ws + WS_SS0);
      for (int m = gw; m < M; m += NGW) { const f32x4* xr = (const f32x4*)(x + (size_t)m * D) + lane; u32x2* o8 = (u32x2*)(xb + (size_t)(m >> 8) * 8 * 65536 + (size_t)(m & 255) * 256) + lane; float s = 0.f;
#pragma unroll
          for (int j = 0; j < 8; ++j) { const f32x4 v = __builtin_nontemporal_load(xr + 64 * j); s += (v[0] * v[0] + v[1] * v[1]) + (v[2] * v[2] + v[3] * v[3]); u32x2 w; w.x = pk2(v[0], v[1]); w.y = pk2(v[2], v[3]); o8[(size_t)j * (65536 / 4)] = w; }
          s = wave_sum(s); if (lane < 32) ss0[(size_t)m * 32 + lane] = lane == 0 ? s : 0.f; } }
    { const float* p = a.in[1]; bf16* pb = (bf16*)(ws + WS_PB); const size_t n8 = (size_t)2 * M * PLE / 8;
      for (size_t i = (size_t)blockIdx.x * 512 + tid; i < n8; i += (size_t)G * 512) { const f32x4 v0 = *(const f32x4*)(p + i * 8), v1 = *(const f32x4*)(p + i * 8 + 4);
          u32x4 w; w.x = pk2(v0[0], v0[1]); w.y = pk2(v0[2], v0[3]); w.z = pk2(v1[0], v1[1]); w.w = pk2(v1[2], v1[3]); *(u32x4*)(pb + i * 8) = w; } }
    { f32x2* rt = (f32x2*)(ws + WS_ROPE);
      for (int i = blockIdx.x * 512 + tid; i < SEQ * 8; i += G * 512) { const int pos = i >> 3, j = i & 7;
          const float ang = __fmul_rn((float)pos, a.invf[j]); const double rev = (double)ang * 0.15915494309189535; const float fr = (float)(rev - __builtin_rint(rev));
          rt[i] = (f32x2){__builtin_amdgcn_cosf(fr), __builtin_amdgcn_sinf(fr)}; } }
}

__device__ __forceinline__ s16x4 tr_read(const LAS bf16* p) { return __builtin_bit_cast(s16x4, __builtin_amdgcn_ds_read_tr16_b64_v4i16((LAS s16x4*)p)); }

#define XB_TMO      128
#define XB_XCNT(j)  (256  + 64 * (j))
#define XB_XSUB(j)  (1280 + 64 * (j))
#define XB_XGEN(j)  (2304 + 64 * (j))
#define XB_TOP      3328
#define XB_TOPGEN   3392
#define XCD_BAR_WORDS 3456
#define XB_SPIN_CAP (1u << 18)

__device__ __forceinline__ unsigned xb_ld(unsigned* p)              { return __hip_atomic_load(p, __ATOMIC_RELAXED, __HIP_MEMORY_SCOPE_AGENT); }
__device__ __forceinline__ unsigned xb_add(unsigned* p, unsigned v) { return __hip_atomic_fetch_add(p, v, __ATOMIC_RELAXED, __HIP_MEMORY_SCOPE_AGENT); }
__device__ __forceinline__ unsigned xb_xcc_id() { return (unsigned)__builtin_amdgcn_s_getreg((3 << 11) | 20) & 0xFu; }
#define XB_SPIN(cond, bar) do { unsigned _sp = 0; while (cond) { __builtin_amdgcn_s_sleep(1); \
    if ((++_sp & 255u) == 0u) { if (xb_ld(&(bar)[XB_TMO])) break; if (_sp > XB_SPIN_CAP) { atomicAdd(&(bar)[XB_TMO], 1u); break; } } } } while (0)

struct XcdBarrier {
    unsigned* bar; unsigned x;
    volatile LAS unsigned* st;
};

__device__ __forceinline__ XcdBarrier xcd_barrier_post(unsigned* bar, volatile LAS unsigned* st) {
    XcdBarrier b; b.bar = bar; b.x = xb_xcc_id(); b.st = st;
    if (threadIdx.x == 0) (void)xb_add(&bar[XB_XCNT(b.x)], 1u);
    return b;
}
__device__ __forceinline__ void xcd_barrier_complete(unsigned* bar, unsigned x, unsigned& nloc, unsigned& nx) {
    const unsigned G = gridDim.x * gridDim.y * gridDim.z;
    unsigned sum, cnt, mine, sp = 0u;
    for (;;) {
        sum = 0u; cnt = 0u; mine = 0u;
#pragma unroll
        for (unsigned j = 0; j < 16; ++j) { const unsigned c = xb_ld(&bar[XB_XCNT(j)]); sum += c; cnt += (c > 0u) ? 1u : 0u; mine = (j == x) ? c : mine; }
        if (sum == G) break;
        __builtin_amdgcn_s_sleep(1);
        if ((++sp & 255u) == 0u) { if (xb_ld(&bar[XB_TMO])) break; if (sp > XB_SPIN_CAP) { atomicAdd(&bar[XB_TMO], 1u); break; } }
    }
    nloc = mine > 0u ? mine : 1u; nx = cnt > 0u ? cnt : 1u;
}

__device__ __forceinline__ void xcd_barrier(const XcdBarrier& b) {
    asm volatile("s_waitcnt vmcnt(0)" ::: "memory");
    __syncthreads();
    if (threadIdx.x == 0) {
        unsigned* bar = b.bar;
        __builtin_amdgcn_s_waitcnt(0);
        unsigned nloc = b.st[0], nx = b.st[1];
        if (nloc == 0u) { xcd_barrier_complete(bar, b.x, nloc, nx); b.st[0] = nloc; b.st[1] = nx; }
        const unsigned old = xb_add(&bar[XB_XSUB(b.x)], 1u);
        const unsigned gen = old / nloc;
        if (old + 1u == (gen + 1u) * nloc) {
            __builtin_amdgcn_fence(__ATOMIC_RELEASE, "agent");
            asm volatile("s_waitcnt vmcnt(0)" ::: "memory");
            const unsigned og = xb_add(&bar[XB_TOP], 1u);
            const unsigned tg = og / nx;
            if (og + 1u == (tg + 1u) * nx) xb_add(&bar[XB_TOPGEN], 1u);
            else XB_SPIN(xb_ld(&bar[XB_TOPGEN]) == tg, bar);
            __builtin_amdgcn_fence(__ATOMIC_ACQUIRE, "agent");
            xb_add(&bar[XB_XGEN(b.x)], 1u);
            asm volatile("s_waitcnt vmcnt(0)" ::: "memory");
        } else {
            XB_SPIN(xb_ld(&bar[XB_XGEN(b.x)]) == gen, bar);
            __builtin_amdgcn_fence(__ATOMIC_ACQUIRE, "agent");
            asm volatile("s_waitcnt vmcnt(0)" ::: "memory");
        }
    }
    __syncthreads();
}

constexpr size_t ARENA_E = (size_t)(4u << 20) / 2;
struct Team { bool on, same; int pm, j; unsigned* cnt; unsigned* tmo; };
__device__ __forceinline__ bool team_mode() { return gridDim.x == 256; }
__device__ __forceinline__ int my_pm() { const int c = blockIdx.x; return 8 * (c & 7) + ((c >> 3) & 7); }
__device__ __forceinline__ size_t panel_adj(int pm, int ld) { return team_mode() ? (size_t)pm * (ARENA_E - (size_t)256 * ld) : 0; }
__device__ __forceinline__ size_t arena_adj(int ld) { return panel_adj(my_pm(), ld); }
__device__ __forceinline__ size_t h_pstride() { return team_mode() ? ARENA_E : (size_t)(FF / 128) * 32768; }
__device__ __forceinline__ void team_barrier(const Team& T) {
    asm volatile("s_waitcnt vmcnt(0)" ::: "memory");
    __syncthreads();
    if (threadIdx.x == 0) {
        __builtin_amdgcn_s_waitcnt(0);
        if (!T.same) { __builtin_amdgcn_fence(__ATOMIC_RELEASE, "agent"); asm volatile("s_waitcnt vmcnt(0)" ::: "memory"); }
        const unsigned old = xb_add(T.cnt, 1u), target = (old / 4u + 1u) * 4u;
        XB_SPIN(xb_ld(T.cnt) < target, T.tmo);
        __builtin_amdgcn_fence(__ATOMIC_ACQUIRE, "agent");
        asm volatile("s_waitcnt vmcnt(0)" ::: "memory");
    }
    __syncthreads();
}
__device__ __forceinline__ void spatial_phase(LAS unsigned char* lds, const bf16* Z, bf16* GT, const float* vstat, const float* lng, const float* lnb, const float* wsp, const float* bsp) {
    const int tid = threadIdx.x, lane = tid & 63, wid = tid >> 6, fr = lane & 15, fq = lane >> 4, q4 = (lane & 15) >> 2, p4 = lane & 3;
    constexpr int WP = 136, VP = 272;
    LAS bf16* Wl = (LAS bf16*)lds;
    LAS bf16* Vl = (LAS bf16*)(lds + 128 * WP * 2);
    LAS float* MU = (LAS float*)(lds + 128 * WP * 2 + 128 * VP * 2);
    LAS float* RS = MU + 128;
    const int th = wid >> 2, cq = wid & 3;
    const int NUNIT = (M / 128) * 16;
    if ((int)blockIdx.x >= NUNIT) return;
    int g = -1; const int c8 = (tid & 31) * 8; int ch = 0;
    f32x4 g0, g1, b0, b1; float bsv[4];
#define SP_STAGE_G(GG) do { g = (GG); ch = g * 256 + c8; const float* wg_ = wsp + (size_t)g * 128 * 128; \
        _Pragma("unroll") for (int j = 0; j < 8; ++j) { const int e = tid + 512 * j, t = e >> 5, s4 = (e & 31) * 4; f32x4 v = *(const f32x4*)(wg_ + t * 128 + s4); \
            _Pragma("unroll") for (int k = 0; k < 4; ++k) if (s4 + k > t) v[k] = 0.f; \
            u32x2 w; w.x = pk2(v[0], v[1]); w.y = pk2(v[2], v[3]); *(LAS u32x2*)(Wl + t * WP + s4) = w; } \
        g0 = *(const f32x4*)(lng + ch); g1 = *(const f32x4*)(lng + ch + 4); b0 = *(const f32x4*)(lnb + ch); b1 = *(const f32x4*)(lnb + ch + 4); \
        _Pragma("unroll") for (int tt = 0; tt < 4; ++tt) bsv[tt] = bsp[g * 128 + th * 64 + tt * 16 + fr]; } while (0)
    for (int idx = blockIdx.x; idx < NUNIT; idx += gridDim.x) {
        const int chunk = idx >> 4; const size_t rowb = (size_t)chunk * 128;
        const size_t zpan = (size_t)(chunk >> 1) * 2097152; const int zrow = (chunk & 1) * 128;
        if ((idx & 15) != g) SP_STAGE_G(idx & 15);
        u32x4 vw[8]; float s1 = 0.f, s2 = 0.f;
        { const int row = tid >> 2, qq = tid & 3; const f32x4* sp = (const f32x4*)(vstat + ((rowb + row) * 64 + qq * 16) * 2);
          f32x4 sv[8];
#pragma unroll
          for (int j = 0; j < 8; ++j) sv[j] = sp[j];
#pragma unroll
          for (int j = 0; j < 8; ++j) vw[j] = *(const u32x4*)(Z + zpan + (size_t)(16 + g) * 65536 + (size_t)(zrow + (tid >> 5) + 16 * j) * 256 + c8);
#pragma unroll
          for (int j = 0; j < 8; ++j) { s1 += sv[j][0] + sv[j][2]; s2 += sv[j][1] + sv[j][3]; }
          s1 += __shfl_xor(s1, 1); s1 += __shfl_xor(s1, 2); s2 += __shfl_xor(s2, 1); s2 += __shfl_xor(s2, 2);
          const float mean = s1 * (1.0f / GW), var = fmaxf(s2 * (1.0f / GW) - mean * mean, 0.f);
          if (qq == 0) { MU[row] = mean; RS[row] = __builtin_amdgcn_rsqf(var + 1e-5f); } }
        __syncthreads();
#pragma unroll
        for (int j = 0; j < 8; ++j) { const int sr = (tid >> 5) + 16 * j; const u32x4 w = vw[j]; const float mu = MU[sr], rs = RS[sr];
            f32x4 v0 = (f32x4){bflo(w.x), bfhi(w.x), bflo(w.y), bfhi(w.y)}, v1 = (f32x4){bflo(w.z), bfhi(w.z), bflo(w.w), bfhi(w.w)};
            v0 = (v0 - mu) * rs * g0 + b0; v1 = (v1 - mu) * rs * g1 + b1;
            u32x4 o; o.x = pk2(v0[0], v0[1]); o.y = pk2(v0[2], v0[3]); o.z = pk2(v1[0], v1[1]); o.w = pk2(v1[2], v1[3]); *(LAS u32x4*)(Vl + sr * VP + c8) = o; }
        u32x2 uw[4][4];
#pragma unroll
        for (int tt = 0; tt < 4; ++tt)
#pragma unroll
            for (int ct = 0; ct < 4; ++ct) uw[tt][ct] = *(const u32x2*)(Z + zpan + (size_t)g * 65536 + (size_t)(zrow + th * 64 + tt * 16 + fr) * 256 + cq * 64 + ct * 16 + 4 * fq);
        __syncthreads();
        f32x4 acc[4][4];
#pragma unroll
        for (int i = 0; i < 4; ++i)
#pragma unroll
            for (int j = 0; j < 4; ++j) acc[i][j] = (f32x4){0.f, 0.f, 0.f, 0.f};
#pragma unroll
        for (int ks = 0; ks < 4; ++ks) {
            bf16x8 wf[4], vf[4];
#pragma unroll
            for (int tt = 0; tt < 4; ++tt) wf[tt] = *(const LAS bf16x8*)(Wl + (th * 64 + tt * 16 + fr) * WP + ks * 32 + fq * 8);
#pragma unroll
            for (int ct = 0; ct < 4; ++ct) { const LAS bf16* vp = Vl + (ks * 32 + 8 * fq + q4) * VP + cq * 64 + ct * 16 + 4 * p4;
                const s16x4 lo = tr_read(vp), hi = tr_read(vp + 4 * VP); vf[ct] = (bf16x8){lo[0], lo[1], lo[2], lo[3], hi[0], hi[1], hi[2], hi[3]}; }
#pragma unroll
            for (int ct = 0; ct < 4; ++ct)
#pragma unroll
                for (int tt = 0; tt < 4; ++tt) acc[ct][tt] = __builtin_amdgcn_mfma_f32_16x16x32_bf16(vf[ct], wf[tt], acc[ct][tt], 0, 0, 0);
        }
#pragma unroll
        for (int tt = 0; tt < 4; ++tt) { const int t = th * 64 + tt * 16 + fr; const float bv_ = bsv[tt];
#pragma unroll
            for (int ct = 0; ct < 4; ++ct) { const u32x2 w = uw[tt][ct]; bf16* up = GT + zpan + (size_t)g * 65536 + (size_t)(zrow + t) * 256 + cq * 64 + ct * 16 + 4 * fq;
                u32x2 o; o.x = pk2(bflo(w.x) * (acc[ct][tt][0] + bv_), bfhi(w.x) * (acc[ct][tt][1] + bv_)); o.y = pk2(bflo(w.y) * (acc[ct][tt][2] + bv_), bfhi(w.y) * (acc[ct][tt][3] + bv_)); *(u32x2*)up = o; } }
        __syncthreads();
    }
#undef SP_STAGE_G
}

__device__ __forceinline__ void attn_phase(LAS unsigned char* lds, const bf16* QKV, bf16* O, const float* rope, const float* sinks) {
    const size_t adjq = team_mode() ? ARENA_E - (size_t)256 * QKVW : 0, adjo = team_mode() ? ARENA_E - (size_t)256 * D : 0;
    const int tid = threadIdx.x, lane = tid & 63, wid = tid >> 6, fr = lane & 15, fq = lane >> 4, q4 = (lane & 15) >> 2, p4 = lane & 3;
    constexpr int KP = 72;
    LAS bf16* Kl = (LAS bf16*)lds;
    LAS bf16* Vl = (LAS bf16*)(lds + 272 * KP * 2);
    constexpr int NB = SEQ / 128, NU = BATCH * NB * NKV;
    const int r = tid >> 1, half = tid & 1;
    if (tid < 32) {
#pragma unroll
        for (int c = 0; c < 4; ++c) { *(LAS u32x4*)(Kl + (256 + r) * KP + half * 32 + 8 * c) = (u32x4){0u, 0u, 0u, 0u}; *(LAS u32x4*)(Vl + (256 + r) * KP + half * 32 + 8 * c) = (u32x4){0u, 0u, 0u, 0u}; } }
    u32x4 kw[4], vw[4]; f32x4 kr[4];
#define ATT_LOAD_KV(IDX) do { const int kh_ = (IDX) & 3, nb_ = ((IDX) >> 2) % NB, b_ = (IDX) / (4 * NB); const int pos_ = (nb_ - 1) * 128 + r; \
        if (pos_ >= 0) { const size_t krow_ = (size_t)b_ * SEQ + pos_; const bf16* kp_ = QKV + krow_ * QKVW + (krow_ >> 8) * adjq + 2048 + kh_ * 64 + half * 32; \
            _Pragma("unroll") for (int c = 0; c < 4; ++c) { kw[c] = *(const u32x4*)(kp_ + 8 * c); vw[c] = *(const u32x4*)(kp_ + 256 + 8 * c); } \
            const f32x4* rp_ = (const f32x4*)(rope + (size_t)pos_ * 16); _Pragma("unroll") for (int c = 0; c < 4; ++c) kr[c] = rp_[c]; \
        } else { _Pragma("unroll") for (int c = 0; c < 4; ++c) { kw[c] = (u32x4){0u, 0u, 0u, 0u}; vw[c] = (u32x4){0u, 0u, 0u, 0u}; kr[c] = (f32x4){1.f, 0.f, 1.f, 0.f}; } } } while (0)
    int idx = blockIdx.x;
    if (idx < NU) ATT_LOAD_KV(idx);
    while (idx < NU) {
        const int kh = idx & 3, nb = (idx >> 2) % NB, b = idx / (4 * NB);
        { if (half == 0) {
              const float cs[8] = {kr[0][0], kr[0][2], kr[1][0], kr[1][2], kr[2][0], kr[2][2], kr[3][0], kr[3][2]}, sn[8] = {kr[0][1], kr[0][3], kr[1][1], kr[1][3], kr[2][1], kr[2][3], kr[3][1], kr[3][3]};
              float x1[8], x2[8];
#pragma unroll
              for (int e = 0; e < 4; ++e) { x1[2 * e] = bflo(kw[0][e]); x1[2 * e + 1] = bfhi(kw[0][e]); x2[2 * e] = bflo(kw[1][e]); x2[2 * e + 1] = bfhi(kw[1][e]); }
#pragma unroll
              for (int e = 0; e < 4; ++e) { kw[0][e] = pk2(x1[2 * e] * cs[2 * e] - x2[2 * e] * sn[2 * e], x1[2 * e + 1] * cs[2 * e + 1] - x2[2 * e + 1] * sn[2 * e + 1]);
                                            kw[1][e] = pk2(x2[2 * e] * cs[2 * e] + x1[2 * e] * sn[2 * e], x2[2 * e + 1] * cs[2 * e + 1] + x1[2 * e + 1] * sn[2 * e + 1]); } }
#pragma unroll
          for (int c = 0; c < 4; ++c) { *(LAS u32x4*)(Kl + r * KP + half * 32 + 8 * c) = kw[c]; *(LAS u32x4*)(Vl + r * KP + half * 32 + 8 * c) = vw[c]; } }
        __syncthreads();
        const int nidx = idx + gridDim.x;
        if (nidx < NU) ATT_LOAD_KV(nidx);
        const int qh = kh * 8 + wid; const float sink = sinks[qh];
        const size_t qrow0 = (size_t)b * SEQ + nb * 128 + fr;
        u32x4 qw0, qw1; f32x4 qr[4];
#define ATT_LOAD_Q(A) do { const size_t qrw_ = qrow0 + (A) * 16; const bf16* qp_ = QKV + qrw_ * QKVW + (qrw_ >> 8) * adjq + qh * 64 + fq * 8; qw0 = *(const u32x4*)qp_; qw1 = *(const u32x4*)(qp_ + 32); \
        const f32x4* rp_ = (const f32x4*)(rope + (size_t)(nb * 128 + (A) * 16 + fr) * 16); _Pragma("unroll") for (int c = 0; c < 4; ++c) qr[c] = rp_[c]; } while (0)
        ATT_LOAD_Q(0);
        for (int a = 0; a < 8; ++a) {
            const int qi = a * 16 + fr; const size_t qrow = qrow0 + a * 16;
            bf16x8 qf[2];
            { u32x4 w0 = qw0; const u32x4 w1 = qw1;
              const float cs[8] = {qr[0][0], qr[0][2], qr[1][0], qr[1][2], qr[2][0], qr[2][2], qr[3][0], qr[3][2]}, sn[8] = {qr[0][1], qr[0][3], qr[1][1], qr[1][3], qr[2][1], qr[2][3], qr[3][1], qr[3][3]};
              u32x4 pw; pw.x = __shfl_xor(w0.x, 16); pw.y = __shfl_xor(w0.y, 16); pw.z = __shfl_xor(w0.z, 16); pw.w = __shfl_xor(w0.w, 16);
              const float sg = fq == 0 ? -1.f : 1.f;
              u32x4 rw;
#pragma unroll
              for (int e = 0; e < 4; ++e) { const float xa = bflo(w0[e]), xb = bfhi(w0[e]), pa = bflo(pw[e]), pb = bfhi(pw[e]);
                  rw[e] = pk2(xa * cs[2 * e] + sg * pa * sn[2 * e], xb * cs[2 * e + 1] + sg * pb * sn[2 * e + 1]); }
              if (fq < 2) w0 = rw;
              qf[0] = __builtin_bit_cast(bf16x8, w0); qf[1] = __builtin_bit_cast(bf16x8, w1); }
            if (a < 7) ATT_LOAD_Q(a + 1);
            f32x4 sc[10];
#pragma unroll
            for (int j = 0; j < 10; ++j) { const LAS bf16* kp = Kl + ((a + j) * 16 + fr) * KP + fq * 8;
                f32x4 z = (f32x4){0.f, 0.f, 0.f, 0.f};
                z = __builtin_amdgcn_mfma_f32_16x16x32_bf16(*(const LAS bf16x8*)kp, qf[0], z, 0, 0, 0);
                z = __builtin_amdgcn_mfma_f32_16x16x32_bf16(*(const LAS bf16x8*)(kp + 32), qf[1], z, 0, 0, 0);
                sc[j] = z; }
            const int qpos = 128 + qi; float mx = -INFINITY;
#pragma unroll
            for (int j = 0; j < 10; ++j)
#pragma unroll
                for (int e = 0; e < 4; ++e) { const int kpos = (a + j) * 16 + 4 * fq + e; const bool valid = (kpos <= qpos) && (kpos > qpos - 128) && (nb > 0 || kpos >= 128);
                    const float sv = valid ? sc[j][e] * 0.125f : -INFINITY; sc[j][e] = sv; mx = fmaxf(mx, sv); }
            mx = fmaxf(mx, __shfl_xor(mx, 16)); mx = fmaxf(mx, __shfl_xor(mx, 32)); mx = fmaxf(mx, sink);
            float l = 0.f;
#pragma unroll
            for (int j = 0; j < 10; ++j)
#pragma unroll
                for (int e = 0; e < 4; ++e) { const float p = __expf(sc[j][e] - mx); sc[j][e] = p; l += p; }
            l += __shfl_xor(l, 16); l += __shfl_xor(l, 32); l += __expf(sink - mx);
            const float rl = 1.0f / l;
            f32x4 oacc[4];
#pragma unroll
            for (int c = 0; c < 4; ++c) oacc[c] = (f32x4){0.f, 0.f, 0.f, 0.f};
#pragma unroll
            for (int j2 = 0; j2 < 5; ++j2) {
                u32x4 pwv; pwv.x = pk2(sc[2 * j2][0], sc[2 * j2][1]); pwv.y = pk2(sc[2 * j2][2], sc[2 * j2][3]); pwv.z = pk2(sc[2 * j2 + 1][0], sc[2 * j2 + 1][1]); pwv.w = pk2(sc[2 * j2 + 1][2], sc[2 * j2 + 1][3]);
                const bf16x8 pf = __builtin_bit_cast(bf16x8, pwv);
#pragma unroll
                for (int c = 0; c < 4; ++c) { const LAS bf16* vp = Vl + ((a + 2 * j2) * 16 + 4 * fq + q4) * KP + 16 * c + 4 * p4;
                    const s16x4 lo = tr_read(vp), hi = tr_read(vp + 16 * KP);
                    const bf16x8 vf = (bf16x8){lo[0], lo[1], lo[2], lo[3], hi[0], hi[1], hi[2], hi[3]};
                    oacc[c] = __builtin_amdgcn_mfma_f32_16x16x32_bf16(vf, pf, oacc[c], 0, 0, 0); }
            }
            bf16* op = O + qrow * D + (qrow >> 8) * adjo + qh * 64 + 4 * fq;
#pragma unroll
            for (int c = 0; c < 4; ++c) { u32x2 w; w.x = pk2(oacc[c][0] * rl, oacc[c][1] * rl); w.y = pk2(oacc[c][2] * rl, oacc[c][3] * rl); *(u32x2*)(op + 16 * c) = w; }
        }
        __syncthreads();
        idx = nidx;
    }
#undef ATT_LOAD_KV
#undef ATT_LOAD_Q
}

__device__ __forceinline__ void final_phase(float* x, const float* ssq, const float* gn, bool team) {
    const int tid = threadIdx.x, lane = tid & 63, wave = tid >> 6; const int gw = blockIdx.x * 8 + wave, NGW = gridDim.x * 8;
    const int mbeg = team ? my_pm() * 256 + (int)(blockIdx.x >> 6) * 64 + wave : gw, mend = team ? my_pm() * 256 + (int)(blockIdx.x >> 6) * 64 + 64 : M, mstep = team ? 8 : NGW;
    for (int m = mbeg; m < mend; m += mstep) { float s = ssq[(size_t)m * 32 + (lane & 31)];
#pragma unroll
        for (int o = 1; o < 32; o <<= 1) s += __shfl_xor(s, o);
        const float rs = __builtin_amdgcn_rsqf(s * (1.0f / D) + 1e-6f); f32x4* xr = (f32x4*)(x + (size_t)m * D) + lane; const f32x4* gr = (const f32x4*)gn + lane;
#pragma unroll
        for (int j = 0; j < 8; ++j) xr[64 * j] = xr[64 * j] * rs * gr[64 * j]; }
}

__device__ __forceinline__ const LAS float* stage_rstd(LAS unsigned char* lds, const float* ssqp, int N) {
    if (gridDim.x != 256) return nullptr;
    pg8::StaticOrder S; S.init(M, N, 256, blockIdx.x); pg8::Unit u; if (!S.next(0, u)) return nullptr;
    LAS float* RS = (LAS float*)(lds + 131072 + 2048);
    const int t = threadIdx.x;
    if (t < 256) { const f32x4* p = (const f32x4*)(ssqp + (size_t)(u.pm * 256 + t) * 32); float sm = 0.f;
#pragma unroll
        for (int j = 0; j < 8; ++j) { const f32x4 v = p[j]; sm += (v[0] + v[1]) + (v[2] + v[3]); }
        RS[t] = __builtin_amdgcn_rsqf(sm * (1.0f / D) + 1e-6f); }
    __syncthreads();
    return RS;
}
#define IN(k) (lo <= (k) && (k) < hi)
#define SEAM(k) do { if (IN(k) && IN((k) + 1)) xcd_barrier(bar); } while (0)
#define SEAM_T(k) do { if (IN(k) && IN((k) + 1)) { if (T.on) team_barrier(T); else xcd_barrier(bar); } } while (0)
template <int F, int L> __device__ __forceinline__ void ph_ffn_up(const Args& a, LAS unsigned char* lds) {
    unsigned char* ws = a.ws;
    pg8::Gemm g{(const bf16*)(ws + WS_XB0), (const bf16*)(ws + WS_W13 + (size_t)(F * 2 + L) * SZ_W13), M, 2 * FF, D, 256, (size_t)256 * D * 2, 131072, 2}; pg8::StaticOrder S; S.init(M, 2 * FF, gridDim.x, blockIdx.x);
    pg8::EpiSwiGLU E{(bf16*)(ws + WS_BIG), h_pstride(), (const float*)(ws + WS_SS0), stage_rstd(lds, (const float*)(ws + WS_SS0), 2 * FF)};
    pg8::gemm_phase<pg8::EpiSwiGLU, pg8::StaticOrder, true, true>(lds, g, S, E);
}
template <int L> __device__ __forceinline__ void ph_ple_proj(const Args& a, LAS unsigned char* lds) {
    unsigned char* ws = a.ws;
    pg8::Gemm g{(const bf16*)(ws + WS_PB) + (size_t)L * M * PLE, (const bf16*)(ws + WS_WP + (size_t)L * SZ_WP), M, D, PLE, PLE}; pg8::StaticOrder S; S.init(M, D, gridDim.x, blockIdx.x);
    pg8::EpiQKV E{(bf16*)(ws + WS_PJ), D, nullptr, nullptr, nullptr, nullptr, nullptr};
    pg8::gemm_phase<pg8::EpiQKV, pg8::StaticOrder, true, true>(lds, g, S, E);
}
template <int F, int L> __device__ __forceinline__ void ph_ffn_down(const Args& a, LAS unsigned char* lds) {
    unsigned char* ws = a.ws;
    pg8::Gemm g{(const bf16*)(ws + WS_BIG), (const bf16*)(ws + WS_W2 + (size_t)(F * 2 + L) * SZ_W2), M, D, FF, 128, h_pstride() * 2, 65536, 1}; pg8::StaticOrder S; S.init(M, D, gridDim.x, blockIdx.x);
    constexpr bool FIRST = (F == 0 && L == 0);
    pg8::EpiResid<FIRST> E{a.in[0], (const bf16*)(ws + WS_XB0), (bf16*)(ws + WS_XB1), (float*)(ws + WS_SS1), nullptr, 0.5f};
    pg8::gemm_phase<pg8::EpiResid<FIRST>, pg8::StaticOrder, true, true>(lds, g, S, E);
}
template <int L> __device__ __forceinline__ void ph_mix_out(const Args& a, LAS unsigned char* lds) {
    unsigned char* ws = a.ws;
    pg8::Gemm g = (L == 0) ? pg8::Gemm{(const bf16*)(ws + WS_BIG), (const bf16*)(ws + WS_WOUT), M, D, GW, 256, (size_t)4 << 20, 131072, 2}
                           : pg8::Gemm{(const bf16*)(ws + WS_BIG) + (team_mode() ? (size_t)256 * QKVW + arena_adj(D) : (size_t)M * QKVW), (const bf16*)(ws + WS_WO), M, D, D, D};
    pg8::StaticOrder S; S.init(M, D, gridDim.x, blockIdx.x);
    pg8::EpiResid<false> E{nullptr, (const bf16*)(ws + WS_XB1), (bf16*)(ws + WS_XB0), (float*)(ws + WS_SS0), L == 0 ? nullptr : a.in[28], 1.0f};
    pg8::gemm_phase<pg8::EpiResid<false>, pg8::StaticOrder, true, true>(lds, g, S, E);
}
template <int L> __device__ __forceinline__ void ph_mix_in(const Args& a, LAS unsigned char* lds) {
    unsigned char* ws = a.ws;
    if constexpr (L == 0) {
        pg8::Gemm g{(const bf16*)(ws + WS_XB1), (const bf16*)(ws + WS_WIN), M, 2 * GW, D, 256, (size_t)256 * D * 2, 131072, 2}; pg8::StaticOrder S; S.init(M, 2 * GW, gridDim.x, blockIdx.x);
        pg8::EpiGelu E{(bf16*)(ws + WS_BIG), 2 * GW, (const float*)(ws + WS_SS1), (float*)(ws + WS_VSTAT), stage_rstd(lds, (const float*)(ws + WS_SS1), 2 * GW)};
        pg8::gemm_phase<pg8::EpiGelu, pg8::StaticOrder, true, true>(lds, g, S, E);
    } else {
        pg8::Gemm g{(const bf16*)(ws + WS_XB1), (const bf16*)(ws + WS_WQKV), M, QKVW, D, 256, (size_t)256 * D * 2, 131072, 2}; pg8::StaticOrder S; S.init(M, QKVW, gridDim.x, blockIdx.x);
        pg8::EpiQKV E{(bf16*)(ws + WS_BIG) + arena_adj(QKVW), QKVW, (const float*)(ws + WS_SS1), a.in[21], a.in[23], a.in[25], stage_rstd(lds, (const float*)(ws + WS_SS1), QKVW)};
        pg8::gemm_phase<pg8::EpiQKV, pg8::StaticOrder, true, true>(lds, g, S, E);
    }
}
template <int L> __device__ __forceinline__ void ph_ple_gate(const Args& a, LAS unsigned char* lds) {
    unsigned char* ws = a.ws;
    pg8::Gemm g{(const bf16*)(ws + WS_XB1), (const bf16*)(ws + WS_WG + (size_t)L * SZ_WG), M, D, D, 256, (size_t)256 * D * 2, 131072, 2}; pg8::StaticOrder S; S.init(M, D, gridDim.x, blockIdx.x);
    pg8::EpiPLE<(L == 1)> E{(const bf16*)(ws + WS_XB1), a.out, (bf16*)(ws + WS_XB0), (float*)(ws + WS_SS0), (const float*)(ws + WS_SS1), (const bf16*)(ws + WS_PJ), stage_rstd(lds, (const float*)(ws + WS_SS1), D)};
    pg8::gemm_phase<pg8::EpiPLE<(L == 1)>, pg8::StaticOrder, true, true>(lds, g, S, E);
}
template <int L> __device__ __forceinline__ void layer(const Args& a, LAS unsigned char* lds, const int lo, const int hi, const XcdBarrier& bar, const Team& T) {
    constexpr int P = 1 + 8 * L; unsigned char* ws = a.ws;
    if (IN(P + 0)) ph_ffn_up<0, L>(a, lds);
    SEAM_T(P + 0);
    if (IN(P + 1)) ph_ffn_down<0, L>(a, lds);
    SEAM_T(P + 1);
    if (IN(P + 2)) ph_mix_in<L>(a, lds);
    SEAM(P + 2);
    if (IN(P + 3)) {
        if constexpr (L == 0) spatial_phase(lds, (const bf16*)(ws + WS_BIG), (bf16*)(ws + WS_BIG), (const float*)(ws + WS_VSTAT), a.in[15], a.in[16], a.in[17], a.in[18]);
        else attn_phase(lds, (const bf16*)(ws + WS_BIG), (bf16*)(ws + WS_BIG) + (team_mode() ? (size_t)256 * QKVW : (size_t)M * QKVW), (const float*)(ws + WS_ROPE), a.in[26]);
    }
    SEAM(P + 3);
    if (IN(P + 4)) ph_mix_out<L>(a, lds);
    SEAM_T(P + 4);
    if (IN(P + 5)) { ph_ffn_up<1, L>(a, lds); ph_ple_proj<L>(a, lds); }
    SEAM_T(P + 5);
    if (IN(P + 6)) ph_ffn_down<1, L>(a, lds);
    SEAM_T(P + 6);
    if (IN(P + 7)) ph_ple_gate<L>(a, lds);
    SEAM_T(P + 7);
}
__global__ void __launch_bounds__(512, 2) mega_fwd(Args a) {
    extern __shared__ __attribute__((aligned(16))) unsigned char lds_raw[];
    LAS unsigned char* lds = (LAS unsigned char*)lds_raw;
    const int lo = a.lo, hi = a.hi;
    unsigned* barw = (unsigned*)(a.ws + WS_CTL);
    volatile LAS unsigned* MISC = (volatile LAS unsigned*)(lds + MISC_OFF);
    if (threadIdx.x < 16) MISC[threadIdx.x] = 0u;
    if (IN(0)) {
        if (blockIdx.x == 0) for (int i = threadIdx.x; i < 8192; i += 512) __hip_atomic_store(barw + i, 0u, __ATOMIC_RELAXED, __HIP_MEMORY_SCOPE_AGENT);
        if (threadIdx.x == 0) __hip_atomic_store(barw + 8192 + blockIdx.x, xb_xcc_id() + 1u, __ATOMIC_RELAXED, __HIP_MEMORY_SCOPE_AGENT);
        p0_prologue(a, lds);
    }
    __syncthreads();
    XcdBarrier bar; bar.bar = barw; bar.x = 0; bar.st = nullptr;
    Team T; T.on = false; T.same = false; T.pm = my_pm(); T.j = blockIdx.x >> 6; T.cnt = barw + 4096 + 64 * T.pm; T.tmo = barw;
    if (IN(0) && IN(1)) { cg::this_grid().sync(); bar = xcd_barrier_post(barw, MISC + 8);
        if (team_mode() && lo == 0 && hi == NPHASE) {
            if (threadIdx.x == 0) { const unsigned me = xb_xcc_id() + 1u; bool sm = true;
#pragma unroll
                for (int j = 0; j < 4; ++j) sm = sm && (xb_ld(barw + 8192 + (blockIdx.x & 63) + 64 * j) == me);
                MISC[12] = sm ? 1u : 0u; }
            __syncthreads();
            T.on = true; T.same = MISC[12] != 0u; } }
    layer<0>(a, lds, lo, hi, bar, T);
    layer<1>(a, lds, lo, hi, bar, T);
    if (IN(NPHASE - 1)) final_phase(a.out, (const float*)(a.ws + WS_SS0), a.in[29], T.on);
}
#undef IN
#undef SEAM
#undef SEAM_T

extern "C" void kernel_launch(void* const* d_in, const int* in_sizes, int n_in, void* d_out, int out_size, void* d_ws, size_t ws_size, hipStream_t stream) {
    static int grid = 0;
    if (grid == 0) {
        if (n_in != 30 || in_sizes[0] != M * D || out_size != M * D || ws_size < WS_END) { fprintf(stderr, "kernel_launch: unexpected shapes / workspace (n_in %d, in0 %d, out %d, ws %zu, need %zu)\n", n_in, n_in > 0 ? in_sizes[0] : -1, out_size, ws_size, (size_t)WS_END); grid = -1; return; }
        int dev = 0, cus = 0, per_cu = 0;
        if (hipGetDevice(&dev) != hipSuccess || hipDeviceGetAttribute(&cus, hipDeviceAttributeMultiprocessorCount, dev) != hipSuccess) { grid = -1; return; }
        if (hipFuncSetAttribute((const void*)mega_fwd, hipFuncAttributeMaxDynamicSharedMemorySize, LDS_BYTES) != hipSuccess) { fprintf(stderr, "kernel_launch: hipFuncSetAttribute failed\n"); grid = -1; return; }
        if (hipOccupancyMaxActiveBlocksPerMultiprocessor(&per_cu, (const void*)mega_fwd, 512, LDS_BYTES) != hipSuccess || per_cu < 1) { fprintf(stderr, "kernel_launch: occupancy query says %d blocks per CU\n", per_cu); per_cu = 1; }
        (void)hipGetLastError();
        grid = cus * (per_cu > 1 ? 1 : per_cu);
    }
    if (grid < 0) return;
    Args a{};
    for (int i = 0; i < 30; ++i) a.in[i] = (const float*)d_in[i];
    a.out = (float*)d_out; a.ws = (unsigned char*)d_ws;
    for (int j = 0; j < 8; ++j) a.invf[j] = (float)pow(500000.0, -(double)(2 * j) / 16.0);
#if MK_MULTI
    for (int ph = 0; ph < NPHASE; ++ph) { a.lo = ph; a.hi = ph + 1; hipLaunchKernelGGL(mega_fwd, dim3(grid), dim3(512), LDS_BYTES, stream, a); }
#else
    a.lo = 0; a.hi = NPHASE;
    void* args[] = {&a};
    hipError_t e = hipLaunchCooperativeKernel((const void*)mega_fwd, dim3(grid), dim3(512), args, LDS_BYTES, stream);
    if (e != hipSuccess) fprintf(stderr, "kernel_launch: cooperative launch failed: %s (grid %d)\n", hipGetErrorString(e), grid);
#endif
}
```
